# Optimizing an MI355X kernel written in HIP

```python
import jax, jax.numpy as jnp
from jax import lax
import numpy as np

D_MODEL = 2048
BATCH = 2
SEQ = 4096
DEPTH = 1
DEC_BATCH = 32
DEC_SEQ = 4
PAST_LEN = 16384
PAGE_SIZE = 128

GLA_WIDTH = D_MODEL // 2
N_GLA_HEADS = 4
GLA_DV = GLA_WIDTH // N_GLA_HEADS
GLA_DK = GLA_DV // 2
GLA_KEY_WIDTH = N_GLA_HEADS * GLA_DK
GLA_GATE_RANK = 16
GLA_GATE_NORM = 16.0
GLA_CHUNK = 16
ATT_WIDTH = D_MODEL - GLA_WIDTH
N_ATT_HEADS = 8
ATT_HEAD_DIM = ATT_WIDTH // N_ATT_HEADS
DILATED_CONFIGS = ((128, 1), (512, 4), (2048, 16))
MAX_WINDOW = 2048
SUB_WINDOW = 128
ATT_BLOCK = 128
D_FF = 4 * D_MODEL
RMS_EPS = 1e-6
IN_COLS = 2 * GLA_KEY_WIDTH + 2 * GLA_WIDTH + GLA_GATE_RANK + 3 * ATT_WIDTH

kernel_name = 'hymba_gla_dilated_alibi_decode_step'


def rmsnorm(x, w):
    xf = x.astype(jnp.float32)
    r = lax.rsqrt(jnp.mean(xf * xf, axis=-1, keepdims=True) + RMS_EPS)
    return (xf * r).astype(x.dtype) * w


def alibi_slopes():
    h = jnp.arange(1, N_ATT_HEADS + 1, dtype=jnp.float32)
    return jnp.exp2(-8.0 * h / N_ATT_HEADS)


def mixer_inputs(x, attn_norm_w, w_in, w_gk_up, b_gk):
    B, T, _ = x.shape
    h = rmsnorm(x, attn_norm_w)
    proj = h @ w_in
    sizes = [GLA_KEY_WIDTH, GLA_KEY_WIDTH, GLA_WIDTH, GLA_WIDTH, GLA_GATE_RANK, ATT_WIDTH, ATT_WIDTH]
    cuts = [int(c) for c in np.cumsum(sizes)]
    gq, gk, gv, gg, glr, aq, ak, av = jnp.split(proj, cuts, axis=-1)
    log_a = jax.nn.log_sigmoid((glr @ w_gk_up + b_gk).astype(jnp.float32)) / GLA_GATE_NORM
    gla = (gq.reshape(B, T, N_GLA_HEADS, GLA_DK) * (GLA_DK ** -0.5),
           gk.reshape(B, T, N_GLA_HEADS, GLA_DK),
           gv.reshape(B, T, N_GLA_HEADS, GLA_DV),
           log_a.reshape(B, T, N_GLA_HEADS, GLA_DK))
    att = tuple(a.reshape(B, T, N_ATT_HEADS, ATT_HEAD_DIM) for a in (aq, ak, av))
    return gla, gg, att


def gla_chunked(q, k, v, log_a, s0):
    f32 = jnp.float32
    B, T = q.shape[0], q.shape[1]
    nc = -(-T // GLA_CHUNK)
    pad = nc * GLA_CHUNK - T
    def blocks(a):
        a = jnp.pad(a.astype(f32), ((0, 0), (0, pad), (0, 0), (0, 0)))
        return a.reshape(B, nc, GLA_CHUNK, a.shape[2], a.shape[3]).transpose(1, 0, 3, 2, 4)
    qc, kc, vc, gc = blocks(q), blocks(k), blocks(v), blocks(log_a)
    bc = jnp.cumsum(gc, axis=3)
    causal = jnp.tril(jnp.ones((GLA_CHUNK, GLA_CHUNK), dtype=bool))[:, :, None]

    def step(S, inp):
        qb, kb, vb, bb = inp
        b_last = bb[:, :, -1, :]
        o_inter = jnp.einsum('bhck,bhkv->bhcv', qb * jnp.exp(bb), S)
        diff = bb[:, :, :, None, :] - bb[:, :, None, :, :]
        decay = jnp.exp(jnp.where(causal, diff, -jnp.inf))
        A = jnp.einsum('bhtk,bhsk,bhtsk->bhts', qb, kb, decay)
        o_intra = jnp.einsum('bhts,bhsv->bhtv', A, vb)
        S_new = jnp.exp(b_last)[..., None] * S + jnp.einsum(
            'bhsk,bhsv->bhkv', kb * jnp.exp(b_last[:, :, None, :] - bb), vb)
        return S_new, o_inter + o_intra

    S_fin, o = lax.scan(step, s0.astype(f32), (qc, kc, vc, bc))
    o = o.transpose(1, 0, 3, 2, 4).reshape(B, nc * GLA_CHUNK, N_GLA_HEADS, GLA_DV)[:, :T]
    return o, S_fin


def strided_window_attention_prompt(q, k, v, dil, slopes):
    B, S, H, E = q.shape
    L = S // dil
    nb = -(-L // ATT_BLOCK)
    Lp = nb * ATT_BLOCK
    Bd = B * dil
    def sub(a):
        a = a.reshape(B, L, dil, H, E).transpose(0, 2, 1, 3, 4).reshape(Bd, L, H, E)
        return jnp.pad(a, ((0, 0), (0, Lp - L), (0, 0), (0, 0)))
    qs, ks, vs = sub(q), sub(k), sub(v)
    qb = qs.reshape(Bd, nb, ATT_BLOCK, H, E)
    def band(a):
        prev = jnp.pad(a, ((0, 0), (ATT_BLOCK, 0), (0, 0), (0, 0)))[:, :Lp]
        return jnp.concatenate([prev.reshape(Bd, nb, ATT_BLOCK, H, E),
                                a.reshape(Bd, nb, ATT_BLOCK, H, E)], axis=2)
    kb, vb = band(ks), band(vs)
    s = jnp.einsum('bnqhe,bnkhe->bnhqk', qb, kb,
                   preferred_element_type=jnp.float32) * (E ** -0.5)
    qi = jnp.arange(ATT_BLOCK)[:, None]
    ki = jnp.arange(2 * ATT_BLOCK)[None, :]
    dist = qi - ki + ATT_BLOCK
    key_idx = jnp.arange(nb)[:, None, None] * ATT_BLOCK - ATT_BLOCK + ki[None]
    valid = (dist >= 0)[None] & (dist <= SUB_WINDOW)[None] & (key_idx >= 0)
    bias = -slopes[:, None, None] * (dil * dist).astype(jnp.float32)[None]
    s = jnp.where(valid[None, :, None], s + bias[None, None], -jnp.inf)
    lse = jax.nn.logsumexp(s, axis=-1)
    p = jnp.exp(s - lse[..., None])
    o = jnp.einsum('bnhqk,bnkhe->bnqhe', p.astype(v.dtype), vb)
    o = o.reshape(Bd, Lp, H, E)[:, :L].reshape(B, dil, L, H, E).transpose(0, 2, 1, 3, 4).reshape(B, S, H, E)
    lse = lse.transpose(0, 1, 3, 2).reshape(Bd, Lp, H)[:, :L].reshape(B, dil, L, H).transpose(0, 2, 1, 3).reshape(B, S, H)
    return o, lse


def strided_window_attention_sample(q, k_all, v_all, w_cache, dil, slopes):
    B, T, H, E = q.shape
    J = SUB_WINDOW + 1
    j = jnp.arange(J)
    idx = w_cache + jnp.arange(T)[:, None] - dil * j[None, :]
    valid = idx >= 0
    idx_c = jnp.clip(idx, 0, None).reshape(-1)
    kg = jnp.take(k_all, idx_c, axis=1).reshape(B, T, J, H, E)
    vg = jnp.take(v_all, idx_c, axis=1).reshape(B, T, J, H, E)
    s = jnp.einsum('bthe,btjhe->bhtj', q, kg,
                   preferred_element_type=jnp.float32) * (E ** -0.5)
    bias = -slopes[:, None, None] * (dil * j).astype(jnp.float32)[None, None, :]
    s = jnp.where(valid[None, None], s + bias[None], -jnp.inf)
    lse = jax.nn.logsumexp(s, axis=-1)
    p = jnp.exp(s - lse[..., None])
    o = jnp.einsum('bhtj,btjhe->bthe', p.astype(v_all.dtype), vg)
    return o, lse.transpose(0, 2, 1)


def combine_dilations(outs, lses):
    w = jax.nn.softmax(jnp.stack(lses, 0), axis=0)
    return jnp.einsum('gbth,gbthe->bthe', w.astype(outs[0].dtype), jnp.stack(outs, 0))


def layer_output(x, gla_o, gg, att_o, gla_norm_w, att_out_norm_w, w_out,
                 ffn_norm_w, w_up, w_down):
    B, T, _ = x.shape
    gla_part = rmsnorm(gla_o, gla_norm_w) * jax.nn.silu(gg.astype(jnp.float32)).reshape(B, T, N_GLA_HEADS, GLA_DV)
    gla_part = gla_part.reshape(B, T, GLA_WIDTH).astype(x.dtype)
    att_part = rmsnorm(att_o.reshape(B, T, ATT_WIDTH), att_out_norm_w).astype(x.dtype)
    x = x + jnp.concatenate([gla_part, att_part], axis=-1) @ w_out
    h = rmsnorm(x, ffn_norm_w)
    return x + jnp.square(jax.nn.relu(h @ w_up)) @ w_down


def setup_inputs(seed: int = 0) -> dict:
    key = jax.random.key(seed)
    ks = jax.random.split(key, 16)
    f32 = jnp.float32
    w_s = min(MAX_WINDOW, PAST_LEN)
    def nrm(k, shape, scale):
        return scale * jax.random.normal(k, shape, f32)
    def gain(k, shape):
        return 1.0 + 0.01 * jax.random.normal(k, shape, f32)
    return {
        'x_prompt': nrm(ks[0], (BATCH, SEQ, D_MODEL), 1.0),
        'x_sample': nrm(ks[1], (DEC_BATCH, DEC_SEQ, D_MODEL), 1.0),
        'cache_k_win': nrm(ks[2], (DEPTH, DEC_BATCH, w_s, N_ATT_HEADS, ATT_HEAD_DIM), 1.0),
        'cache_v_win': nrm(ks[3], (DEPTH, DEC_BATCH, w_s, N_ATT_HEADS, ATT_HEAD_DIM), 1.0),
        'state_gla': nrm(ks[4], (DEPTH, DEC_BATCH, N_GLA_HEADS, GLA_DK, GLA_DV), 0.5),
        'attn_norm_w': gain(ks[5], (DEPTH, D_MODEL)),
        'w_in': nrm(ks[6], (DEPTH, D_MODEL, IN_COLS), D_MODEL ** -0.5),
        'w_gk_up': nrm(ks[7], (DEPTH, GLA_GATE_RANK, GLA_KEY_WIDTH), GLA_GATE_RANK ** -0.5),
        'b_gk': nrm(ks[8], (DEPTH, GLA_KEY_WIDTH), 0.1),
        'gla_norm_w': gain(ks[9], (DEPTH, GLA_DV)),
        'att_out_norm_w': gain(ks[10], (DEPTH, ATT_WIDTH)),
        'w_out': nrm(ks[11], (DEPTH, D_MODEL, D_MODEL), D_MODEL ** -0.5),
        'ffn_norm_w': gain(ks[12], (DEPTH, D_MODEL)),
        'w_up': nrm(ks[13], (DEPTH, D_MODEL, D_FF), D_MODEL ** -0.5),
        'w_down': nrm(ks[14], (DEPTH, D_FF, D_MODEL), D_FF ** -0.5),
        'final_norm_w': gain(ks[15], (D_MODEL,)),
    }


def reference(x_prompt, x_sample, cache_k_win, cache_v_win, state_gla,
              attn_norm_w, w_in, w_gk_up, b_gk, gla_norm_w, att_out_norm_w, w_out,
              ffn_norm_w, w_up, w_down, final_norm_w):
    slopes = alibi_slopes()
    xp, xs = x_prompt, x_sample
    S = xp.shape[1]
    w_p = min(MAX_WINDOW, S)
    w_s = cache_k_win.shape[2]
    kp_l, vp_l, sp_l, ks_l, vs_l, ss_l = [], [], [], [], [], []
    for l in range(DEPTH):
        (gq, gk, gv, ga), gg, (aq, ak, av) = mixer_inputs(xp, attn_norm_w[l], w_in[l], w_gk_up[l], b_gk[l])
        s0 = jnp.zeros((xp.shape[0], N_GLA_HEADS, GLA_DK, GLA_DV), jnp.float32)
        gla_o, s_fin_p = gla_chunked(gq, gk, gv, ga, s0)
        outs, lses = [], []
        for _, dil in DILATED_CONFIGS:
            o, lse = strided_window_attention_prompt(aq, ak, av, dil, slopes)
            outs.append(o)
            lses.append(lse)
        att_o = combine_dilations(outs, lses)
        xp = layer_output(xp, gla_o, gg, att_o, gla_norm_w[l], att_out_norm_w[l], w_out[l],
                          ffn_norm_w[l], w_up[l], w_down[l])
        kp_l.append(ak[:, S - w_p:])
        vp_l.append(av[:, S - w_p:])
        sp_l.append(s_fin_p)
        (gq, gk, gv, ga), gg, (aq, ak, av) = mixer_inputs(xs, attn_norm_w[l], w_in[l], w_gk_up[l], b_gk[l])
        gla_o, s_fin_s = gla_chunked(gq, gk, gv, ga, state_gla[l])
        k_all = jnp.concatenate([cache_k_win[l].astype(ak.dtype), ak], axis=1)
        v_all = jnp.concatenate([cache_v_win[l].astype(av.dtype), av], axis=1)
        outs, lses = [], []
        for _, dil in DILATED_CONFIGS:
            o, lse = strided_window_attention_sample(aq, k_all, v_all, w_s, dil, slopes)
            outs.append(o)
            lses.append(lse)
        att_o = combine_dilations(outs, lses)
        xs = layer_output(xs, gla_o, gg, att_o, gla_norm_w[l], att_out_norm_w[l], w_out[l],
                          ffn_norm_w[l], w_up[l], w_down[l])
        ks_l.append(ak)
        vs_l.append(av)
        ss_l.append(s_fin_s)
    y_prompt = rmsnorm(xp, final_norm_w)
    y_sample = rmsnorm(xs, final_norm_w)
    k_win_prompt = jnp.stack(kp_l, 0)
    v_win_prompt = jnp.stack(vp_l, 0)
    gla_prompt = jnp.stack(sp_l, 0)
    k_new_sample = jnp.stack(ks_l, 0)
    v_new_sample = jnp.stack(vs_l, 0)
    gla_sample = jnp.stack(ss_l, 0)
    return (y_prompt, y_sample, k_win_prompt, v_win_prompt, gla_prompt,
            k_new_sample, v_new_sample, gla_sample)
```

```cpp
#include <hip/hip_runtime.h>
#include <hip/hip_cooperative_groups.h>
#include <cstdio>
namespace cg = cooperative_groups;

#define LAS __attribute__((address_space(3)))
typedef unsigned short bf16_t;
typedef short bf16x8 __attribute__((ext_vector_type(8)));
typedef float f32x4 __attribute__((ext_vector_type(4)));
typedef float f32x2 __attribute__((ext_vector_type(2)));
typedef unsigned u32x4 __attribute__((ext_vector_type(4)));
typedef unsigned u32x2 __attribute__((ext_vector_type(2)));

constexpr int DM = 2048, TP = 8192, TS = 128, MT = TP + TS, SEQ = 4096, DFF = 8192;
constexpr int N1 = 6144;
constexpr float EPS = 1e-6f;
constexpr float LOG2E = 1.4426950408889634f;
constexpr int NTHR = 512;
constexpr int LDS_BYTES = 147456;
#ifndef PH_MASK
#define PH_MASK 0x1ff
#endif
#ifndef REP_MASK
#define REP_MASK 0
#endif
#define NREP(b) ((REP_MASK & (b)) ? 2 : 1)

constexpr size_t OUT_YP = 0, OUT_YS = 16777216, OUT_KW = 17039360, OUT_VW = 21233664, OUT_GP = 25427968,
                 OUT_KN = 25690112, OUT_VN = 25821184, OUT_GS = 25952256;

constexpr size_t al(size_t x) { return (x + 255) & ~(size_t)255; }
constexpr size_t O_BAR = 0;
constexpr size_t O_SUMS = 16384;
constexpr size_t O_RSTD1 = O_SUMS + al((size_t)MT * 4);
constexpr size_t O_GLR = O_RSTD1 + al((size_t)MT * 4);
constexpr size_t O_XB = O_GLR + al((size_t)MT * 16 * 4);
constexpr size_t O_BT1 = O_XB + al((size_t)MT * DM * 2);
constexpr size_t O_BTG = O_BT1 + al((size_t)N1 * DM * 2);
constexpr size_t O_BTO = O_BTG + al((size_t)16 * DM * 2);
constexpr size_t O_BTU = O_BTO + al((size_t)DM * DM * 2);
constexpr size_t O_BTD = O_BTU + al((size_t)DFF * DM * 2);
constexpr size_t O_GQ = O_BTD + al((size_t)DM * DFF * 2);
constexpr size_t O_GK = O_GQ + al((size_t)MT * 512 * 2);
constexpr size_t O_GV = O_GK + al((size_t)MT * 512 * 2);
constexpr size_t O_GG = O_GV + al((size_t)MT * 1024 * 2);
constexpr size_t O_AQ = O_GG + al((size_t)MT * 1024 * 2);
constexpr size_t O_AK = O_AQ + al((size_t)MT * 1024 * 2);
constexpr size_t O_AV = O_AK + al((size_t)MT * 1024 * 2);
constexpr size_t O_BCUM = O_AV + al((size_t)MT * 1024 * 2);
constexpr size_t O_DS = O_BCUM + al((size_t)TP * 512 * 4);
constexpr size_t O_SC = O_DS + al((size_t)512 * 128 * 256 * 4);
constexpr size_t O_DEC = O_SC + al((size_t)512 * 128 * 256 * 2);
constexpr size_t O_OATT = O_DEC + al((size_t)512 * 128 * 4);
constexpr size_t O_LSE = O_OATT + al((size_t)3 * TP * 1024 * 2);
constexpr size_t O_ATTS = O_LSE + al((size_t)3 * TP * 8 * 4);
constexpr size_t O_GLAOS = O_ATTS + al((size_t)TS * 1024 * 4);
constexpr size_t O_CAT = O_GLAOS + al((size_t)TS * 1024 * 4);
constexpr size_t O_X1 = O_CAT + al((size_t)MT * DM * 2);
constexpr size_t O_X1B = O_X1 + al((size_t)MT * DM * 4);
constexpr size_t O_HM = O_X1B + al((size_t)MT * DM * 2);
constexpr size_t O_ACC1 = O_HM + al((size_t)MT * DFF * 2);
constexpr size_t O_ACCO = O_ACC1 + al((size_t)8 * TS * N1 * 4);
constexpr size_t O_ACCU = O_ACCO + al((size_t)8 * TS * DM * 4);
constexpr size_t O_ACCD = O_ACCU + al((size_t)8 * TS * DFF * 4);
constexpr size_t WS_END = O_ACCD + al((size_t)32 * TS * DM * 4) + (size_t)4 * 1024 * 1024;
__device__ __forceinline__ f32x4 acc1_4(const float* ACC1, int srow, int col) {
    f32x4 s = *(const f32x4*)(ACC1 + (size_t)srow * N1 + col);
#pragma unroll
    for (int kp = 1; kp < 8; ++kp) s += *(const f32x4*)(ACC1 + ((size_t)kp * TS + srow) * N1 + col);
    return s;
}
__device__ __forceinline__ float acc1_1(const float* ACC1, int srow, int col) {
    float s = ACC1[(size_t)srow * N1 + col];
#pragma unroll
    for (int kp = 1; kp < 8; ++kp) s += ACC1[((size_t)kp * TS + srow) * N1 + col];
    return s;
}

struct P {
    const float *x_prompt, *x_sample, *cache_k, *cache_v, *state_gla, *attn_norm_w, *w_in, *w_gk_up, *b_gk, *gla_norm_w,
        *att_out_norm_w, *w_out, *ffn_norm_w, *w_up, *w_down, *final_norm_w;
    float* out;
    unsigned char* ws;
};

__device__ __forceinline__ unsigned cvt_pk_bf16(float lo, float hi) { unsigned r; asm volatile("v_cvt_pk_bf16_f32 %0, %1, %2" : "=v"(r) : "v"(lo), "v"(hi)); return r; }
__device__ __forceinline__ bf16_t f2bf(float f) { return (bf16_t)(cvt_pk_bf16(f, 0.f) & 0xffffu); }
__device__ __forceinline__ float bflo(unsigned u) { return __uint_as_float(u << 16); }
__device__ __forceinline__ float bfhi(unsigned u) { return __uint_as_float(u & 0xffff0000u); }
__device__ __forceinline__ float bf2f(bf16_t b) { return __uint_as_float(((unsigned)b) << 16); }
__device__ __forceinline__ float wave_sum(float v) {
#pragma unroll
    for (int o = 1; o < 64; o <<= 1) v += __shfl_xor(v, o);
    return v;
}
__device__ __forceinline__ int fresh_tid() { int t = threadIdx.x; asm volatile("" : "+v"(t)); return t; }
__device__ __forceinline__ float fexp2(float x) { return __builtin_amdgcn_exp2f(x); }
__device__ __forceinline__ float flog2(float x) { return __builtin_amdgcn_logf(x); }
__device__ __forceinline__ unsigned offb(unsigned row, unsigned ch) { return 256u * row + 16u * (ch ^ (((row & 3u) << 2) | ((row >> 2) & 3u))); }
__device__ __forceinline__ bf16x8 tr_read2(unsigned a0, unsigned a1) {
    u32x2 r0, r1;
    asm volatile("ds_read_b64_tr_b16 %0, %2\n\tds_read_b64_tr_b16 %1, %3\n\ts_waitcnt lgkmcnt(0)" : "=&v"(r0), "=&v"(r1) : "v"(a0), "v"(a1) : "memory");
    u32x4 r; r.x = r0.x; r.y = r0.y; r.z = r1.x; r.w = r1.y;
    return __builtin_bit_cast(bf16x8, r);
}
__device__ __forceinline__ void tr_read_4x2(const unsigned (&a)[4], bf16x8 (&out)[4]) {
    u32x2 r[8];
    asm volatile(
        "ds_read_b64_tr_b16 %0, %8\n\tds_read_b64_tr_b16 %1, %8 offset:4096\n\t"
        "ds_read_b64_tr_b16 %2, %9\n\tds_read_b64_tr_b16 %3, %9 offset:4096\n\t"
        "ds_read_b64_tr_b16 %4, %10\n\tds_read_b64_tr_b16 %5, %10 offset:4096\n\t"
        "ds_read_b64_tr_b16 %6, %11\n\tds_read_b64_tr_b16 %7, %11 offset:4096\n\t"
        "s_waitcnt lgkmcnt(0)"
        : "=&v"(r[0]), "=&v"(r[1]), "=&v"(r[2]), "=&v"(r[3]), "=&v"(r[4]), "=&v"(r[5]), "=&v"(r[6]), "=&v"(r[7])
        : "v"(a[0]), "v"(a[1]), "v"(a[2]), "v"(a[3])
        : "memory");
#pragma unroll
    for (int i = 0; i < 4; ++i) { u32x4 t; t.x = r[2 * i].x; t.y = r[2 * i].y; t.z = r[2 * i + 1].x; t.w = r[2 * i + 1].y; out[i] = __builtin_bit_cast(bf16x8, t); }
}
__device__ __forceinline__ void tr_read2x2(unsigned a0, unsigned a1, unsigned b0, unsigned b1, bf16x8& fa, bf16x8& fb) {
    u32x2 r0, r1, r2, r3;
    asm volatile("ds_read_b64_tr_b16 %0, %4\n\tds_read_b64_tr_b16 %1, %5\n\tds_read_b64_tr_b16 %2, %6\n\tds_read_b64_tr_b16 %3, %7\n\ts_waitcnt lgkmcnt(0)"
                 : "=&v"(r0), "=&v"(r1), "=&v"(r2), "=&v"(r3) : "v"(a0), "v"(a1), "v"(b0), "v"(b1) : "memory");
    u32x4 x; x.x = r0.x; x.y = r0.y; x.z = r1.x; x.w = r1.y; fa = __builtin_bit_cast(bf16x8, x);
    u32x4 y; y.x = r2.x; y.y = r2.y; y.z = r3.x; y.w = r3.y; fb = __builtin_bit_cast(bf16x8, y);
}
__device__ __forceinline__ bf16x8 pack8(f32x4 a, f32x4 b) {
    u32x4 r; r.x = cvt_pk_bf16(a[0], a[1]); r.y = cvt_pk_bf16(a[2], a[3]); r.z = cvt_pk_bf16(b[0], b[1]); r.w = cvt_pk_bf16(b[2], b[3]);
    return __builtin_bit_cast(bf16x8, r);
}
__device__ __forceinline__ f32x4 mfma16(bf16x8 a, bf16x8 b, f32x4 c) { return __builtin_amdgcn_mfma_f32_16x16x32_bf16(a, b, c, 0, 0, 0); }

namespace pg8 {
constexpr int BM = 256, BK = 64, HALF = 128, HTB = HALF * BK * 2, STAGE_BYTES = 8 * HTB, NXCD = 8, WGM = 8;
__host__ __device__ __forceinline__ int lds_byte(int r, int c) { const int st = (r >> 4) * 2 + (c >> 5), rr = r & 15, cc = c & 31, ob = rr * 64 + cc * 2; return st * 1024 + (ob ^ (((ob >> 9) & 1) << 5)); }
__host__ __device__ __forceinline__ void stage_rc(int b, int& R, int& C) { const int st = b / 1024, sb = b % 1024, swz = sb ^ (((sb >> 9) & 1) << 5); R = (st >> 1) * 16 + swz / 64; C = (st & 1) * 32 + (swz % 64) / 2; }
__host__ __device__ __forceinline__ int perm32(int rho) { const int n = rho >> 4, i = rho & 15; return 8 * (i >> 2) + 4 * n + (i & 3); }
struct Unit { int pm, pn; const char* A; const char* B; int nt, kind; };
struct Gemm { int ld, nt; };
struct StaticOrder {
    int nM, nN, nwg, G, c; const char* Ab; const char* Bb; size_t tstep;
    __device__ void init(const bf16_t* A, const bf16_t* Bt, int M, int N, int ld, int G_, int c_) { nM = M / BM; nN = N / BM; nwg = nM * nN; G = G_; c = c_; Ab = (const char*)A; Bb = (const char*)Bt; tstep = (size_t)BM * ld * 2; }
    __device__ bool next(int i, Unit& u) const {
        const long L = (long)i * G + c; if (L >= nwg) return false;
        int wgid = (int)L; { const int q = nwg / NXCD, r = nwg % NXCD, xcd = wgid % NXCD, off = wgid / NXCD; wgid = (xcd < r ? xcd * (q + 1) : r * (q + 1) + (xcd - r) * q) + off; }
        const int nig = WGM * nN, gid = wgid / nig, fm = gid * WGM, gsz = (nM - fm) < WGM ? (nM - fm) : WGM;
        u.pm = fm + ((wgid % nig) % gsz); u.pn = (wgid % nig) / gsz; u.A = Ab + (size_t)u.pm * tstep; u.B = Bb + (size_t)u.pn * tstep; u.nt = 0; u.kind = 0; return true;
    }
};
struct PieceOrder {
    int nN, nK, G, c; const char* Ab; const char* Bb; size_t tstep, kbytes;
    __device__ void init(const bf16_t* A, const bf16_t* Bt, int N, int ld, int klen, int G_, int c_) { nN = N / BM; nK = ld / klen; G = G_; c = c_; Ab = (const char*)A; Bb = (const char*)Bt; tstep = (size_t)BM * ld * 2; kbytes = (size_t)klen * 2; }
    __device__ bool next(int i, Unit& u) const {
        const int L = i * G + c; if (L >= nN * nK) return false;
        u.pn = L % nN; u.pm = L / nN; u.A = Ab + (size_t)u.pm * kbytes; u.B = Bb + (size_t)u.pn * tstep + (size_t)u.pm * kbytes; u.nt = 0; u.kind = 1; return true;
    }
};

struct CombOrder {
    StaticOrder s; PieceOrder p; int ns, nt_full, nt_piece;
    __device__ void init(const StaticOrder& s_, const PieceOrder& p_, int nt_full_, int nt_piece_) { s = s_; p = p_; nt_full = nt_full_; nt_piece = nt_piece_; ns = s.c < s.nwg ? (s.nwg - 1 - s.c) / s.G + 1 : 0; }
    __device__ bool next(int i, Unit& u) const {
        if (i < ns) { s.next(i, u); u.nt = nt_full; return true; }
        if (p.next(i - ns, u)) { u.nt = nt_piece; return true; }
        return false;
    }
};

template <class Epi, class Sched>
__device__ __forceinline__ void gemm_phase(LAS unsigned char* lds, const Gemm g, const Sched& S, const Epi& E) {
    const int tid = fresh_tid(), wid = __builtin_amdgcn_readfirstlane(tid >> 6), lane = tid & 63, wr = wid >> 2, wc = wid & 3, fr = lane & 15, fq = lane >> 4;
    const int K = g.ld;
    unsigned voffA[2], voffB[2];
#pragma unroll
    for (int i = 0; i < 2; ++i) { int R, C; stage_rc(tid * 16 + i * 8192, R, C); const int Rb = Epi::PERM ? ((R & ~31) + perm32(R & 31)) : R;
        voffA[i] = (unsigned)(R * K + C) * 2u; voffB[i] = (unsigned)(Rb * K + C) * 2u; }
    const size_t kstep = (size_t)(BK * 2);
    const size_t hstep = (size_t)HALF * K * 2;
    const unsigned ldsw = (unsigned)wid * 1024u;
    const int aoff = lds_byte(wr * 64 + fr, fq * 8), boff = lds_byte(wc * 32 + fr, fq * 8);
#define PG8_SA(b, h) (((b) * 2 + (h)) * HTB)
#define PG8_SB(b, h) ((4 + (b) * 2 + (h)) * HTB)
#define PG8_STAGE(bufoff, gbase, voff) do { _Pragma("unroll") for (int _i = 0; _i < 2; ++_i) \
        __builtin_amdgcn_global_load_lds((const unsigned*)((const char*)(gbase) + (voff)[_i]), (LAS unsigned*)(lds + (bufoff) + ldsw + _i * 8192), 16, 0, 0); } while (0)
#define PG8_LDA(dst, b, h) do { _Pragma("unroll") for (int m = 0; m < 4; ++m) _Pragma("unroll") for (int k = 0; k < 2; ++k) dst[m][k] = *(const LAS bf16x8*)(lds + PG8_SA(b, h) + aoff + m * 2048 + k * 1024); } while (0)
#define PG8_LDB(dst, b, h) do { _Pragma("unroll") for (int n = 0; n < 2; ++n) _Pragma("unroll") for (int k = 0; k < 2; ++k) dst[n][k] = *(const LAS bf16x8*)(lds + PG8_SB(b, h) + boff + n * 2048 + k * 1024); } while (0)
#define PG8_MMA(ai, bj, At, Bt) do { __builtin_amdgcn_s_setprio(1); _Pragma("unroll") for (int m = 0; m < 4; ++m) _Pragma("unroll") for (int n = 0; n < 2; ++n) _Pragma("unroll") for (int k = 0; k < 2; ++k) \
        acc[ai][bj][m][n] = __builtin_amdgcn_mfma_f32_16x16x32_bf16(Bt[n][k], At[m][k], acc[ai][bj][m][n], 0, 0, 0); __builtin_amdgcn_s_setprio(0); } while (0)
#define PG8_WAIT_V(n) asm volatile("s_waitcnt vmcnt(" #n ")" ::: "memory")
#define PG8_WAIT_L(n) asm volatile("s_waitcnt lgkmcnt(" #n ")" ::: "memory")
#define PG8_BAR __builtin_amdgcn_s_barrier()
#define PG8_SCHED __builtin_amdgcn_sched_barrier(0)
    Unit cur, nxt; int ui = 0;
    if (!S.next(0, cur)) return;
    int nt = cur.nt ? cur.nt : g.nt;
    f32x4 acc[2][2][4][2];
#pragma unroll
    for (int a = 0; a < 2; ++a)
#pragma unroll
        for (int b = 0; b < 2; ++b)
#pragma unroll
            for (int m = 0; m < 4; ++m)
#pragma unroll
                for (int n = 0; n < 2; ++n) acc[a][b][m][n] = (f32x4){0.f, 0.f, 0.f, 0.f};
    bf16x8 At[4][2], B0[2][2], B1[2][2];
    const char* cA = cur.A; const char* cB = cur.B;
    PG8_STAGE(PG8_SB(0, 0), cB, voffB); PG8_STAGE(PG8_SA(0, 0), cA, voffA); PG8_STAGE(PG8_SB(0, 1), cB + hstep, voffB); PG8_STAGE(PG8_SA(0, 1), cA + hstep, voffA);
    if (wr == 1) PG8_BAR;
    PG8_WAIT_V(4); PG8_BAR;
    PG8_STAGE(PG8_SB(1, 0), cB + kstep, voffB); PG8_STAGE(PG8_SA(1, 0), cA + kstep, voffA); PG8_STAGE(PG8_SB(1, 1), cB + hstep + kstep, voffB);
    PG8_WAIT_V(6); PG8_BAR;
    for (;;) {
        const bool has_next = S.next(ui + 1, nxt);
        const char* nA = has_next ? nxt.A : cA; const char* nB = has_next ? nxt.B : cB;
        for (int t = 0; t < nt; t += 2) {
            const bool last = (t == nt - 2);
            const char* a1 = cA + (size_t)(t + 1) * kstep;
            const char* a2 = last ? nA : cA + (size_t)(t + 2) * kstep; const char* b2 = last ? nB : cB + (size_t)(t + 2) * kstep;
            const char* a3 = a2 + kstep; const char* b3 = b2 + kstep;
            PG8_LDB(B0, 0, 0); PG8_SCHED; PG8_LDA(At, 0, 0); PG8_STAGE(PG8_SA(1, 1), a1 + hstep, voffA);
            PG8_WAIT_L(8); PG8_BAR; PG8_WAIT_L(0); PG8_MMA(0, 0, At, B0); PG8_BAR; PG8_SCHED;
            PG8_LDB(B1, 0, 1); PG8_STAGE(PG8_SB(0, 0), b2, voffB);
            PG8_BAR; PG8_WAIT_L(0); PG8_MMA(0, 1, At, B1); PG8_BAR;
            PG8_LDA(At, 0, 1); PG8_STAGE(PG8_SA(0, 0), a2, voffA);
            PG8_BAR; PG8_WAIT_L(0); PG8_MMA(1, 0, At, B0); PG8_BAR; PG8_SCHED;
            PG8_STAGE(PG8_SB(0, 1), b2 + hstep, voffB);
            PG8_WAIT_V(6); PG8_BAR; PG8_MMA(1, 1, At, B1); PG8_BAR;
            PG8_LDB(B0, 1, 0); PG8_SCHED; PG8_LDA(At, 1, 0); PG8_STAGE(PG8_SA(0, 1), a2 + hstep, voffA);
            PG8_WAIT_L(8); PG8_BAR; PG8_WAIT_L(0); PG8_MMA(0, 0, At, B0); PG8_BAR; PG8_SCHED;
            PG8_LDB(B1, 1, 1); PG8_STAGE(PG8_SB(1, 0), b3, voffB);
            PG8_BAR; PG8_WAIT_L(0); PG8_MMA(0, 1, At, B1); PG8_BAR;
            PG8_LDA(At, 1, 1); PG8_STAGE(PG8_SA(1, 0), a3, voffA);
            PG8_BAR; PG8_WAIT_L(0); PG8_MMA(1, 0, At, B0); PG8_BAR; PG8_SCHED;
            PG8_STAGE(PG8_SB(1, 1), b3 + hstep, voffB);
            PG8_WAIT_V(6); PG8_BAR; PG8_MMA(1, 1, At, B1); PG8_BAR;
        }
        E(acc, cur, wr, wc, fr, fq);
        if (!has_next) break;
#pragma unroll
        for (int a = 0; a < 2; ++a)
#pragma unroll
            for (int b = 0; b < 2; ++b)
#pragma unroll
                for (int m = 0; m < 4; ++m)
#pragma unroll
                    for (int n = 0; n < 2; ++n) acc[a][b][m][n] = (f32x4){0.f, 0.f, 0.f, 0.f};
        cur = nxt; cA = nA; cB = nB; ++ui; nt = cur.nt ? cur.nt : g.nt;
    }
    PG8_WAIT_V(0);
    if (wr == 0) PG8_BAR;
    PG8_BAR;
#undef PG8_SA
#undef PG8_SB
#undef PG8_STAGE
#undef PG8_LDA
#undef PG8_LDB
#undef PG8_MMA
#undef PG8_WAIT_V
#undef PG8_WAIT_L
#undef PG8_BAR
#undef PG8_SCHED
}
}

struct Epi1 {
    static constexpr bool PERM = true;
    P p;
    __device__ __forceinline__ void operator()(const f32x4 (&acc)[2][2][4][2], const pg8::Unit& u, int wr, int wc, int fr, int fq) const {
        unsigned char* ws = p.ws;
        const float* rstd = (const float*)(ws + O_RSTD1);
        const int row0 = u.pm * 256 + wr * 64 + fr, pn = u.pn;
        bf16_t* dst; int ld, cb; float sc = 1.f; float* fo = nullptr;
        if (pn < 2) { dst = (bf16_t*)(ws + O_GQ); ld = 512; cb = pn * 256; sc = 0.08838834764831845f; }
        else if (pn < 4) { dst = (bf16_t*)(ws + O_GK); ld = 512; cb = (pn - 2) * 256; }
        else if (pn < 8) { dst = (bf16_t*)(ws + O_GV); ld = 1024; cb = (pn - 4) * 256; }
        else if (pn < 12) { dst = (bf16_t*)(ws + O_GG); ld = 1024; cb = (pn - 8) * 256; }
        else if (pn < 16) { dst = (bf16_t*)(ws + O_AQ); ld = 1024; cb = (pn - 12) * 256; sc = 0.08838834764831845f * LOG2E; }
        else if (pn < 20) { dst = (bf16_t*)(ws + O_AK); ld = 1024; cb = (pn - 16) * 256; fo = p.out + OUT_KW; }
        else { dst = (bf16_t*)(ws + O_AV); ld = 1024; cb = (pn - 20) * 256; fo = p.out + OUT_VW; }
        float rsv[2][4];
#pragma unroll
        for (int ai = 0; ai < 2; ++ai)
#pragma unroll
            for (int m = 0; m < 4; ++m) rsv[ai][m] = rstd[row0 + ai * 128 + m * 16];
        asm volatile("" ::: "memory");
#pragma unroll
        for (int ai = 0; ai < 2; ++ai)
#pragma unroll
            for (int m = 0; m < 4; ++m) {
                const int row = row0 + ai * 128 + m * 16; const float rs = rsv[ai][m] * sc;
                const int t = row & 4095;
#pragma unroll
                for (int bj = 0; bj < 2; ++bj) {
                    const int c = cb + bj * 128 + wc * 32 + 8 * fq;
                    const f32x4 v0 = acc[ai][bj][m][0] * rs, v1 = acc[ai][bj][m][1] * rs;
                    u32x4 w; w.x = cvt_pk_bf16(v0[0], v0[1]); w.y = cvt_pk_bf16(v0[2], v0[3]); w.z = cvt_pk_bf16(v1[0], v1[1]); w.w = cvt_pk_bf16(v1[2], v1[3]);
                    *(u32x4*)(dst + (size_t)row * ld + c) = w;
                    if (fo && t >= 2048) { float* o = fo + ((size_t)((row >> 12) * 2048 + t - 2048)) * 1024 + c; __builtin_nontemporal_store(v0, (f32x4*)o); __builtin_nontemporal_store(v1, (f32x4*)(o + 4)); }
                }
            }
    }
};

struct EpiO {
    static constexpr bool PERM = true;
    P p;
    __device__ __forceinline__ void operator()(const f32x4 (&acc)[2][2][4][2], const pg8::Unit& u, int wr, int wc, int fr, int fq) const {
        unsigned char* ws = p.ws;
        const bf16_t* XB = (const bf16_t*)(ws + O_XB); bf16_t* X1B = (bf16_t*)(ws + O_X1B); float* ss2 = (float*)(ws + O_SUMS);
        const int row0 = u.pm * 256 + wr * 64 + fr, col0 = u.pn * 256 + wc * 32 + 8 * fq;
        u32x4 xin[2][4][2];
#pragma unroll
        for (int ai = 0; ai < 2; ++ai)
#pragma unroll
            for (int m = 0; m < 4; ++m)
#pragma unroll
                for (int bj = 0; bj < 2; ++bj) xin[ai][m][bj] = __builtin_nontemporal_load((const u32x4*)(XB + (size_t)(row0 + ai * 128 + m * 16) * DM + col0 + bj * 128));
        asm volatile("" ::: "memory");
#pragma unroll
        for (int ai = 0; ai < 2; ++ai)
#pragma unroll
            for (int m = 0; m < 4; ++m) {
                const int row = row0 + ai * 128 + m * 16; float s = 0.f;
#pragma unroll
                for (int bj = 0; bj < 2; ++bj) {
                    const size_t off = (size_t)row * DM + col0 + bj * 128;
                    const u32x4 xr = xin[ai][m][bj];
                    f32x4 v0 = acc[ai][bj][m][0], v1 = acc[ai][bj][m][1];
                    v0[0] += bflo(xr.x); v0[1] += bfhi(xr.x); v0[2] += bflo(xr.y); v0[3] += bfhi(xr.y);
                    v1[0] += bflo(xr.z); v1[1] += bfhi(xr.z); v1[2] += bflo(xr.w); v1[3] += bfhi(xr.w);
                    u32x4 w; w.x = cvt_pk_bf16(v0[0], v0[1]); w.y = cvt_pk_bf16(v0[2], v0[3]); w.z = cvt_pk_bf16(v1[0], v1[1]); w.w = cvt_pk_bf16(v1[2], v1[3]);
                    *(u32x4*)(X1B + off) = w;
                    s += (v0[0] * v0[0] + v0[1] * v0[1]) + (v0[2] * v0[2] + v0[3] * v0[3]) + (v1[0] * v1[0] + v1[1] * v1[1]) + (v1[2] * v1[2] + v1[3] * v1[3]);
                }
                s += __shfl_xor(s, 16); s += __shfl_xor(s, 32);
                if (fq == 0) __hip_atomic_fetch_add(ss2 + row, s, __ATOMIC_RELAXED, __HIP_MEMORY_SCOPE_AGENT);
            }
    }
};

struct EpiU {
    static constexpr bool PERM = true;
    P p;
    __device__ __forceinline__ void operator()(const f32x4 (&acc)[2][2][4][2], const pg8::Unit& u, int wr, int wc, int fr, int fq) const {
        unsigned char* ws = p.ws;
        const float* ss2 = (const float*)(ws + O_SUMS); bf16_t* HM = (bf16_t*)(ws + O_HM);
        const int row0 = u.pm * 256 + wr * 64 + fr, col0 = u.pn * 256 + wc * 32 + 8 * fq;
        float rsv[2][4];
#pragma unroll
        for (int ai = 0; ai < 2; ++ai)
#pragma unroll
            for (int m = 0; m < 4; ++m) rsv[ai][m] = ss2[row0 + ai * 128 + m * 16];
        asm volatile("" ::: "memory");
#pragma unroll
        for (int ai = 0; ai < 2; ++ai)
#pragma unroll
            for (int m = 0; m < 4; ++m) {
                const int row = row0 + ai * 128 + m * 16; const float rs = rsqrtf(rsv[ai][m] * (1.f / DM) + EPS);
#pragma unroll
                for (int bj = 0; bj < 2; ++bj) {
                    f32x4 v0 = acc[ai][bj][m][0] * rs, v1 = acc[ai][bj][m][1] * rs;
#pragma unroll
                    for (int j = 0; j < 4; ++j) { v0[j] = fmaxf(v0[j], 0.f); v0[j] *= v0[j]; v1[j] = fmaxf(v1[j], 0.f); v1[j] *= v1[j]; }
                    u32x4 w; w.x = cvt_pk_bf16(v0[0], v0[1]); w.y = cvt_pk_bf16(v0[2], v0[3]); w.z = cvt_pk_bf16(v1[0], v1[1]); w.w = cvt_pk_bf16(v1[2], v1[3]);
                    *(u32x4*)(HM + (size_t)row * DFF + col0 + bj * 128) = w;
                }
            }
    }
};

struct EpiD {
    static constexpr bool PERM = true;
    P p;
    __device__ __forceinline__ void operator()(const f32x4 (&acc)[2][2][4][2], const pg8::Unit& u, int wr, int wc, int fr, int fq) const {
        const bf16_t* X1B = (const bf16_t*)(p.ws + O_X1B); bf16_t* X2B = (bf16_t*)(p.ws + O_CAT);
        const int row0 = u.pm * 256 + wr * 64 + fr, col0 = u.pn * 256 + wc * 32 + 8 * fq;
        u32x4 xin[2][4][2];
#pragma unroll
        for (int ai = 0; ai < 2; ++ai)
#pragma unroll
            for (int m = 0; m < 4; ++m)
#pragma unroll
                for (int bj = 0; bj < 2; ++bj) xin[ai][m][bj] = __builtin_nontemporal_load((const u32x4*)(X1B + (size_t)(row0 + ai * 128 + m * 16) * DM + col0 + bj * 128));
        asm volatile("" ::: "memory");
#pragma unroll
        for (int ai = 0; ai < 2; ++ai)
#pragma unroll
            for (int m = 0; m < 4; ++m) {
                const int row = row0 + ai * 128 + m * 16;
#pragma unroll
                for (int bj = 0; bj < 2; ++bj) {
                    const size_t off = (size_t)row * DM + col0 + bj * 128;
                    const u32x4 xr = xin[ai][m][bj];
                    f32x4 v0 = acc[ai][bj][m][0], v1 = acc[ai][bj][m][1];
                    v0[0] += bflo(xr.x); v0[1] += bfhi(xr.x); v0[2] += bflo(xr.y); v0[3] += bfhi(xr.y);
                    v1[0] += bflo(xr.z); v1[1] += bfhi(xr.z); v1[2] += bflo(xr.w); v1[3] += bfhi(xr.w);
                    u32x4 w; w.x = cvt_pk_bf16(v0[0], v0[1]); w.y = cvt_pk_bf16(v0[2], v0[3]); w.z = cvt_pk_bf16(v1[0], v1[1]); w.w = cvt_pk_bf16(v1[2], v1[3]);
                    *(u32x4*)(X2B + off) = w;
                }
            }
    }
};

struct EpiPart {
    static constexpr bool PERM = false;
    float* C; int ldc;
    __device__ __forceinline__ void operator()(const f32x4 (&acc)[2][2][4][2], const pg8::Unit& u, int wr, int wc, int fr, int fq) const {
        const int row0 = wr * 64 + fr, col0 = u.pn * 256 + wc * 32 + 4 * fq;
        float* base = C + (size_t)u.pm * TS * ldc;
#pragma unroll
        for (int m = 0; m < 4; ++m) {
            float* rp = base + (size_t)(row0 + m * 16) * ldc + col0;
#pragma unroll
            for (int bj = 0; bj < 2; ++bj)
#pragma unroll
                for (int n = 0; n < 2; ++n) *(f32x4*)(rp + bj * 128 + n * 16) = acc[0][bj][m][n];
        }
    }
};

struct EpiPartP {
    float* C; int ldc;
    __device__ __forceinline__ void operator()(const f32x4 (&acc)[2][2][4][2], const pg8::Unit& u, int wr, int wc, int fr, int fq) const {
        const int row0 = wr * 64 + fr, col0 = u.pn * 256 + wc * 32 + 8 * fq;
        float* base = C + (size_t)u.pm * TS * ldc;
#pragma unroll
        for (int m = 0; m < 4; ++m) {
            float* rp = base + (size_t)(row0 + m * 16) * ldc + col0;
#pragma unroll
            for (int bj = 0; bj < 2; ++bj) { *(f32x4*)(rp + bj * 128) = acc[0][bj][m][0]; *(f32x4*)(rp + bj * 128 + 4) = acc[0][bj][m][1]; }
        }
    }
};
template <class Main> struct EpiBoth {
    static constexpr bool PERM = true, AFTER_DRAIN = false;
    Main m; EpiPartP q;
    __device__ __forceinline__ void operator()(const f32x4 (&acc)[2][2][4][2], const pg8::Unit& u, int wr, int wc, int fr, int fq) const {
        if (u.kind == 0) m(acc, u, wr, wc, fr, fq); else q(acc, u, wr, wc, fr, fq);
    }
};

template <int NB>
__device__ __forceinline__ void skinny(const bf16_t* A, int lda, const bf16_t* Bt, int ldb, int klen, f32x4 (&acc)[NB], int lane) {
    const int fr = lane & 15, fq = lane >> 4;
    const bf16x8* ap = (const bf16x8*)(A + (size_t)fr * lda + fq * 8);
    const bf16x8* bp[NB];
#pragma unroll
    for (int nb = 0; nb < NB; ++nb) { bp[nb] = (const bf16x8*)(Bt + (size_t)(nb * 16 + fr) * ldb + fq * 8); acc[nb] = (f32x4){0.f, 0.f, 0.f, 0.f}; }
    const int nks = klen / 32;
#pragma unroll 8
    for (int ks = 0; ks < nks; ++ks) {
        const bf16x8 a = ap[ks * 4];
#pragma unroll
        for (int nb = 0; nb < NB; ++nb) { const bf16x8 b = bp[nb][ks * 4]; acc[nb] = mfma16(b, a, acc[nb]); }
    }
}

__device__ __forceinline__ void tr_item(const float* W, int ldw, int k0, int n0, int nvalid, const float* nw, bf16_t* WT, int K, int drow0, LAS float* scr, int lane) {
    float tv[64];
    { const float* wp = W + (size_t)k0 * ldw + n0 + (lane < nvalid ? lane : 0);
#pragma unroll
      for (int i = 0; i < 64; ++i) tv[i] = __builtin_nontemporal_load(wp + (size_t)i * ldw);
#pragma unroll
      for (int i = 0; i < 64; ++i) { float v = tv[i]; if (nw) v *= nw[k0 + i]; scr[i * 65 + lane] = v; } }
    asm volatile("s_waitcnt lgkmcnt(0)" ::: "memory");
    const int c = lane & 7;
#pragma unroll
    for (int j = 0; j < 8; ++j) { const int n = (lane >> 3) + 8 * j; const LAS float* s = scr + (8 * c) * 65 + n;
        u32x4 o; o.x = cvt_pk_bf16(s[0 * 65], s[1 * 65]); o.y = cvt_pk_bf16(s[2 * 65], s[3 * 65]); o.z = cvt_pk_bf16(s[4 * 65], s[5 * 65]); o.w = cvt_pk_bf16(s[6 * 65], s[7 * 65]);
        if (n < nvalid) *(u32x4*)(WT + (size_t)(drow0 + n) * K + k0 + 8 * c) = o; }
    asm volatile("s_waitcnt lgkmcnt(0)" ::: "memory");
}

__device__ __forceinline__ void phase0(const P& p, LAS unsigned char* lds, int tid, int G) {
    unsigned char* ws = p.ws;
    const int wave = tid >> 6, lane = tid & 63;
    const int gw = blockIdx.x * 8 + wave, NGW = G * 8;
    float* sums = (float*)(ws + O_SUMS);
    for (int i = blockIdx.x * NTHR + tid; i < MT; i += G * NTHR) sums[i] = 0.f;
    float* rstd1 = (float*)(ws + O_RSTD1); bf16_t* XB = (bf16_t*)(ws + O_XB);
    for (int mb = gw; mb < MT; mb += 2 * NGW) {
        f32x4 v[2][8];
#pragma unroll
        for (int q = 0; q < 2; ++q) { const int m = mb + q * NGW;
            if (m < MT) { const float* xr = m < TP ? p.x_prompt + (size_t)m * DM : p.x_sample + (size_t)(m - TP) * DM;
#pragma unroll
                for (int j = 0; j < 8; ++j) v[q][j] = __builtin_nontemporal_load((const f32x4*)xr + lane + 64 * j); } }
        asm volatile("" ::: "memory");
#pragma unroll
        for (int q = 0; q < 2; ++q) { const int m = mb + q * NGW;
            if (m < MT) { float s = 0.f;
#pragma unroll
                for (int j = 0; j < 8; ++j) s += (v[q][j][0] * v[q][j][0] + v[q][j][1] * v[q][j][1]) + (v[q][j][2] * v[q][j][2] + v[q][j][3] * v[q][j][3]);
                s = wave_sum(s);
                if (lane == 0) rstd1[m] = rsqrtf(s * (1.f / DM) + EPS);
                u32x2* o = (u32x2*)(XB + (size_t)m * DM);
#pragma unroll
                for (int j = 0; j < 8; ++j) { u32x2 w; w.x = cvt_pk_bf16(v[q][j][0], v[q][j][1]); w.y = cvt_pk_bf16(v[q][j][2], v[q][j][3]); o[lane + 64 * j] = w; } } }
    }
    LAS float* scr = (LAS float*)(lds + wave * 16640);
    bf16_t* BT1 = (bf16_t*)(ws + O_BT1); bf16_t* BTG = (bf16_t*)(ws + O_BTG);
    constexpr int I_IN = 32 * 96, I_G = 32;
    constexpr int NIT = I_IN + I_G;
    for (int it = gw; it < NIT; it += NGW) {
        int r = it;
        if (r < I_IN) { const int kb = r / 96, nb = r % 96; const int src_n0 = nb < 48 ? nb * 64 : 3088 + (nb - 48) * 64;
            tr_item(p.w_in, 6160, kb * 64, src_n0, 64, p.attn_norm_w, BT1, DM, nb * 64, scr, lane); continue; }
        r -= I_IN;
        tr_item(p.w_in, 6160, r * 64, 3072, 16, p.attn_norm_w, BTG, DM, 0, scr, lane);
    }
}
__device__ __forceinline__ void side_transposes(const P& p, LAS unsigned char* lds, int sw, int lane, int G) {
    unsigned char* ws = p.ws;
    LAS float* scr = (LAS float*)(lds + sw * 16640);
    bf16_t* BTO = (bf16_t*)(ws + O_BTO); bf16_t* BTU = (bf16_t*)(ws + O_BTU); bf16_t* BTD = (bf16_t*)(ws + O_BTD);
    constexpr int I_O = 32 * 32, I_U = 32 * 128, I_D = 128 * 32;
    for (int it = sw * G + blockIdx.x; it < I_O + I_U + I_D; it += 4 * G) {
        int r = it;
        if (r < I_O) { const int kb = r / 32, nb = r % 32; tr_item(p.w_out, DM, kb * 64, nb * 64, 64, nullptr, BTO, DM, nb * 64, scr, lane); continue; }
        r -= I_O;
        if (r < I_U) { const int kb = r / 128, nb = r % 128; tr_item(p.w_up, DFF, kb * 64, nb * 64, 64, p.ffn_norm_w, BTU, DM, nb * 64, scr, lane); continue; }
        r -= I_U;
        { const int kb = r / 32, nb = r % 32; tr_item(p.w_down, DM, kb * 64, nb * 64, 64, nullptr, BTD, DFF, nb * 64, scr, lane); }
    }
}

__device__ __forceinline__ void phase1_skinny(const P& p, LAS unsigned char* lds, int tid, int G) {
    unsigned char* ws = p.ws;
    const int wave = tid >> 6, lane = tid & 63, fr = lane & 15, fq = lane >> 4;
    const bf16_t* XB = (const bf16_t*)(ws + O_XB); const float* rstd1 = (const float*)(ws + O_RSTD1);
    float* GLR = (float*)(ws + O_GLR);
    const int rg = wave >> 2, kq = wave & 3;
    for (int k = 0; k * G < MT / 32; ++k) {
        const int it = k * G + ((k & 1) ? (G - 1 - (int)blockIdx.x) : (int)blockIdx.x);
        if (it >= MT / 32) break;
        f32x4 acc[1];
        skinny<1>(XB + (size_t)(it * 32 + rg * 16) * DM + kq * 512, DM, (const bf16_t*)(ws + O_BTG) + kq * 512, DM, 512, acc, lane);
        __syncthreads();
        *(LAS f32x4*)(lds + (wave * 64 + lane) * 16) = acc[0];
        __syncthreads();
        if (kq == 0) {
            f32x4 v = acc[0];
#pragma unroll
            for (int q = 1; q < 4; ++q) v += *(const LAS f32x4*)(lds + ((wave + q) * 64 + lane) * 16);
            const int row = it * 32 + rg * 16 + fr;
            *(f32x4*)(GLR + (size_t)row * 16 + 4 * fq) = v * rstd1[row];
        }
    }
}

__device__ __forceinline__ void attn_issue(const P& p, int it, int tid, u32x4 (&kv)[8], u32x4 (&vv)[8], bf16x8 (&qf)[4]) {
    unsigned char* ws = p.ws;
    const int wid = tid >> 6, lane = tid & 63, fr = lane & 15, fq = lane >> 4;
    const int g = it >> 9, rem = it & 511, b = rem >> 8, h = (rem >> 5) & 7, sub = rem & 31;
    const int dsh = 2 * g, d = 1 << dsh, nbs = 5 - dsh;
    const int r = sub >> nbs, n = sub & ((1 << nbs) - 1);
    const bf16_t* AKp = (const bf16_t*)(ws + O_AK) + (size_t)b * SEQ * 1024 + h * 128;
    const bf16_t* AVp = (const bf16_t*)(ws + O_AV) + (size_t)b * SEQ * 1024 + h * 128;
#pragma unroll
    for (int ps = 0; ps < 8; ++ps) {
        const int row = (tid >> 4) + 32 * ps, ch = tid & 15, lk = 128 * (n - 1) + row;
        kv[ps] = (u32x4){0u, 0u, 0u, 0u}; vv[ps] = (u32x4){0u, 0u, 0u, 0u};
        if (lk >= 0) { const size_t t = (size_t)lk * d + r; kv[ps] = *(const u32x4*)(AKp + t * 1024 + ch * 8); vv[ps] = *(const u32x4*)(AVp + t * 1024 + ch * 8); }
    }
    const int tq = (128 * n + 16 * wid + fr) * d + r;
    const bf16_t* qp = (const bf16_t*)(ws + O_AQ) + ((size_t)b * SEQ + tq) * 1024 + h * 128 + fq * 8;
#pragma unroll
    for (int ks = 0; ks < 4; ++ks) qf[ks] = *(const bf16x8*)(qp + 32 * ks);
}

__device__ __forceinline__ void attn_prompt_loop(const P& p, LAS unsigned char* lds, int tid, int G) {
    unsigned char* ws = p.ws;
    const int wid = tid >> 6, lane = tid & 63, fr = lane & 15, fq = lane >> 4;
    u32x4 kvr[8], vvr[8]; bf16x8 qn[4];
    int it = blockIdx.x;
    if (it < 1536) attn_issue(p, it, tid, kvr, vvr, qn);
    for (; it < 1536; it += G) {
    const int g = it >> 9, rem = it & 511, b = rem >> 8, h = (rem >> 5) & 7, sub = rem & 31;
    const int dsh = 2 * g, d = 1 << dsh, nbs = 5 - dsh;
    const int r = sub >> nbs, n = sub & ((1 << nbs) - 1);
    __syncthreads();
#pragma unroll
    for (int ps = 0; ps < 8; ++ps) {
        const int row = (tid >> 4) + 32 * ps, ch = tid & 15;
        *(LAS u32x4*)(lds + offb(row, ch)) = kvr[ps]; *(LAS u32x4*)(lds + 65536 + offb(row, ch)) = vvr[ps];
    }
    const int tq = (128 * n + 16 * wid + fr) * d + r;
    __syncthreads();
    const int kb0 = 2 * (wid >> 1);
    f32x4 sacc[10];
#pragma unroll
    for (int kbi = 0; kbi < 10; ++kbi) {
        sacc[kbi] = (f32x4){0.f, 0.f, 0.f, 0.f};
        const unsigned key = 16 * (kb0 + kbi) + fr;
#pragma unroll
        for (int ks = 0; ks < 4; ++ks) { const bf16x8 kf = *(const LAS bf16x8*)(lds + offb(key, 4 * ks + fq)); sacc[kbi] = mfma16(kf, qn[ks], sacc[kbi]); }
    }
    int rel = 16 * (wid & 1) + fr - 4 * fq; asm volatile("" : "+v"(rel));
    const float slope2 = fexp2(-(float)(h + 1)) * LOG2E * (float)d;
    const float c0 = -slope2 * (float)(rel + 128);
    float mx = -INFINITY;
#pragma unroll
    for (int kbi = 0; kbi < 10; ++kbi) {
        const bool blk_ok = (n > 0) || (kb0 + kbi >= 8);
#pragma unroll
        for (int j = 0; j < 4; ++j) {
            bool valid = blk_ok;
            if (kbi <= 1) valid = valid && (rel - 16 * kbi - j <= 0);
            if (kbi >= 8) valid = valid && (rel + 128 - 16 * kbi - j >= 0);
            const float s = valid ? sacc[kbi][j] + (c0 + slope2 * (float)(16 * kbi + j)) : -INFINITY;
            sacc[kbi][j] = s; mx = fmaxf(mx, s);
        }
    }
    mx = fmaxf(mx, __shfl_xor(mx, 16)); mx = fmaxf(mx, __shfl_xor(mx, 32));
    float l = 0.f;
#pragma unroll
    for (int kbi = 0; kbi < 10; ++kbi)
#pragma unroll
        for (int j = 0; j < 4; ++j) { const float pe = fexp2(sacc[kbi][j] - mx); sacc[kbi][j] = pe; l += pe; }
    l += __shfl_xor(l, 16); l += __shfl_xor(l, 32);
    if (it + G < 1536) attn_issue(p, it + G, tid, kvr, vvr, qn);
    f32x4 oacc[8];
#pragma unroll
    for (int eb = 0; eb < 8; ++eb) oacc[eb] = (f32x4){0.f, 0.f, 0.f, 0.f};
    const unsigned vbase = (unsigned)(size_t)(lds + 65536);
    const unsigned q_ = (lane & 15) >> 2, pp = lane & 3;
    const unsigned a00 = vbase + offb(16 * kb0 + 4 * fq + q_, (pp >> 1)) + 8 * (pp & 1);
#pragma unroll
    for (int ks = 0; ks < 5; ++ks) {
        const bf16x8 pf = pack8(sacc[2 * ks], sacc[2 * ks + 1]);
#pragma unroll
        for (int e4 = 0; e4 < 2; ++e4) {
            unsigned av[4]; bf16x8 vf[4];
#pragma unroll
            for (int eb = 0; eb < 4; ++eb) av[eb] = (a00 + (unsigned)(ks * 8192)) ^ (unsigned)((e4 * 4 + eb) << 5);
            tr_read_4x2(av, vf);
#pragma unroll
            for (int eb = 0; eb < 4; ++eb) oacc[e4 * 4 + eb] = mfma16(vf[eb], pf, oacc[e4 * 4 + eb]);
        }
    }
    const float inv = 1.f / l;
    bf16_t* op = (bf16_t*)(ws + O_OATT) + ((size_t)g * TP + (size_t)b * SEQ + tq) * 1024 + h * 128 + 4 * fq;
#pragma unroll
    for (int eb = 0; eb < 8; ++eb) { const f32x4 o = oacc[eb] * inv; u32x2 w; w.x = cvt_pk_bf16(o[0], o[1]); w.y = cvt_pk_bf16(o[2], o[3]); *(u32x2*)(op + 16 * eb) = w; }
    if (fq == 0) ((float*)(ws + O_LSE))[((size_t)g * TP + (size_t)b * SEQ + tq) * 8 + h] = mx + flog2(l);
    }
}

__device__ __forceinline__ void attn_sample_item(const P& p, int wi, int lane) {
    unsigned char* ws = p.ws;
    const int bs = wi >> 5, i = (wi >> 3) & 3, h = wi & 7;
    const int kg = lane >> 4, li = lane & 15;
    const int srow = bs * 4 + i;
    const float* ACC1 = (const float*)(ws + O_ACC1); const float* rstd1 = (const float*)(ws + O_RSTD1);
    float q[8];
    { const float rq = rstd1[TP + srow] * (0.08838834764831845f * LOG2E);
      const f32x4 q0 = acc1_4(ACC1, srow, 3072 + h * 128 + 8 * li), q1 = acc1_4(ACC1, srow, 3072 + h * 128 + 8 * li + 4);
      q[0] = q0[0] * rq; q[1] = q0[1] * rq; q[2] = q0[2] * rq; q[3] = q0[3] * rq; q[4] = q1[0] * rq; q[5] = q1[1] * rq; q[6] = q1[2] * rq; q[7] = q1[3] * rq; }
    if (kg == 0) {
        const float rs = rstd1[TP + srow];
        float* ko = p.out + OUT_KN + (size_t)srow * 1024 + h * 128 + 8 * li; float* vo = p.out + OUT_VN + (size_t)srow * 1024 + h * 128 + 8 * li;
        *(f32x4*)ko = acc1_4(ACC1, srow, 4096 + h * 128 + 8 * li) * rs; *(f32x4*)(ko + 4) = acc1_4(ACC1, srow, 4096 + h * 128 + 8 * li + 4) * rs;
        *(f32x4*)vo = acc1_4(ACC1, srow, 5120 + h * 128 + 8 * li) * rs; *(f32x4*)(vo + 4) = acc1_4(ACC1, srow, 5120 + h * 128 + 8 * li + 4) * rs;
    }
    float m = -1e30f, l = 0.f, acc[8];
#pragma unroll
    for (int e = 0; e < 8; ++e) acc[e] = 0.f;
    const float sl = fexp2(-(float)(h + 1)) * LOG2E;
    for (int g = 0; g < 3; ++g) {
        const int d = 1 << (2 * g);
#pragma unroll 3
        for (int jj = 0; jj < 33; ++jj) {
            const int j = 4 * jj + kg; const bool valid = j <= 128; const int jc = valid ? j : 128;
            const int idx = 2048 + i - d * jc;
            f32x4 k0, k1, v0, v1;
            if (idx < 2048) { const size_t off = (((size_t)bs * 2048 + idx) * 8 + h) * 128 + 8 * li;
                k0 = __builtin_nontemporal_load((const f32x4*)(p.cache_k + off)); k1 = __builtin_nontemporal_load((const f32x4*)(p.cache_k + off + 4)); v0 = __builtin_nontemporal_load((const f32x4*)(p.cache_v + off)); v1 = __builtin_nontemporal_load((const f32x4*)(p.cache_v + off + 4)); }
            else { const int nr = bs * 4 + (idx - 2048); const float rsn = rstd1[TP + nr]; const int c0 = 4096 + h * 128 + 8 * li;
                k0 = acc1_4(ACC1, nr, c0) * rsn; k1 = acc1_4(ACC1, nr, c0 + 4) * rsn; v0 = acc1_4(ACC1, nr, c0 + 1024) * rsn; v1 = acc1_4(ACC1, nr, c0 + 1028) * rsn; }
            float dot = (q[0] * k0[0] + q[1] * k0[1]) + (q[2] * k0[2] + q[3] * k0[3]) + (q[4] * k1[0] + q[5] * k1[1]) + (q[6] * k1[2] + q[7] * k1[3]);
            dot += __shfl_xor(dot, 1); dot += __shfl_xor(dot, 2); dot += __shfl_xor(dot, 4); dot += __shfl_xor(dot, 8);
            const float s = valid ? dot - sl * (float)(d * j) : -INFINITY;
            const float mn = fmaxf(m, s), sc = fexp2(m - mn), pe = fexp2(s - mn);
            l = l * sc + pe;
            acc[0] = acc[0] * sc + pe * v0[0]; acc[1] = acc[1] * sc + pe * v0[1]; acc[2] = acc[2] * sc + pe * v0[2]; acc[3] = acc[3] * sc + pe * v0[3];
            acc[4] = acc[4] * sc + pe * v1[0]; acc[5] = acc[5] * sc + pe * v1[1]; acc[6] = acc[6] * sc + pe * v1[2]; acc[7] = acc[7] * sc + pe * v1[3];
            m = mn;
        }
    }
    float mt = fmaxf(m, __shfl_xor(m, 16)); mt = fmaxf(mt, __shfl_xor(mt, 32));
    const float f = fexp2(m - mt);
    l *= f; l += __shfl_xor(l, 16); l += __shfl_xor(l, 32);
    const float inv = 1.f / l;
    float* o = (float*)(ws + O_ATTS) + (size_t)srow * 1024 + h * 128 + 8 * li;
#pragma unroll
    for (int e = 0; e < 8; ++e) { float a = acc[e] * f; a += __shfl_xor(a, 16); a += __shfl_xor(a, 32); acc[e] = a * inv; }
    if (kg == 0) { *(f32x4*)o = (f32x4){acc[0], acc[1], acc[2], acc[3]}; *(f32x4*)(o + 4) = (f32x4){acc[4], acc[5], acc[6], acc[7]}; }
}

__device__ __forceinline__ float logsig(float x) { return fminf(x, 0.f) - __logf(1.f + __expf(-fabsf(x))); }

__device__ __forceinline__ void gla_a_item(const P& p, LAS unsigned char* lds, int it, int tid) {
    unsigned char* ws = p.ws;
    const int wid = tid >> 6, lane = tid & 63, fr = lane & 15, fq = lane >> 4;
    const int bh = it >> 6, c = it & 63, b = bh >> 2, h = bh & 3;
    const int row0 = b * SEQ + 64 * c;
    LAS float* sGLR = (LAS float*)lds;
    LAS float* sTot = (LAS float*)(lds + 4096);
    LAS unsigned char* sKt = lds + 8192;
    LAS unsigned char* sV = lds + 8192 + 16384;
    __syncthreads();
    if (tid < 256) *(LAS f32x4*)(sGLR + 4 * tid) = *(const f32x4*)((const float*)(ws + O_GLR) + (size_t)row0 * 16 + 4 * tid);
    const bf16_t* GV = (const bf16_t*)(ws + O_GV);
#pragma unroll
    for (int i = 0; i < 4; ++i) { const int q = tid + 512 * i, row = q >> 5, ch32 = q & 31;
        const u32x4 v = *(const u32x4*)(GV + (size_t)(row0 + row) * 1024 + h * 256 + ch32 * 8);
        *(LAS u32x4*)(sV + (ch32 >> 4) * 16384 + offb(row, ch32 & 15)) = v; }
    const int k = tid & 127, tg = tid >> 7;
    float w[16];
#pragma unroll
    for (int r = 0; r < 16; ++r) w[r] = p.w_gk_up[r * 512 + h * 128 + k];
    const float bias = p.b_gk[h * 128 + k];
    float kvals[16];
    { const bf16_t* GKp = (const bf16_t*)(ws + O_GK) + (size_t)(row0 + tg * 16) * 512 + h * 128 + k;
#pragma unroll
      for (int tt = 0; tt < 16; ++tt) kvals[tt] = bf2f(GKp[(size_t)tt * 512]); }
    __syncthreads();
    float cs[16]; float run = 0.f;
#pragma unroll
    for (int tt = 0; tt < 16; ++tt) { const int t = tg * 16 + tt; float x = bias;
#pragma unroll
        for (int r = 0; r < 16; ++r) x += sGLR[t * 16 + r] * w[r];
        run += logsig(x) * (1.f / 16.f); cs[tt] = run; }
    sTot[tg * 128 + k] = run;
    __syncthreads();
    float off = 0.f, tot = 0.f;
#pragma unroll
    for (int gi = 0; gi < 4; ++gi) { const float v = sTot[gi * 128 + k]; if (gi < tg) off += v; tot += v; }
    float* BCUM = (float*)(ws + O_BCUM);
#pragma unroll
    for (int tt = 0; tt < 16; ++tt) { const int t = tg * 16 + tt; const float bt = off + cs[tt];
        BCUM[(size_t)(row0 + t) * 512 + h * 128 + k] = bt;
        const float kval = kvals[tt];
        *(LAS bf16_t*)(sKt + offb(t, k >> 3) + 2 * (k & 7)) = f2bf(kval * __expf(tot - bt)); }
    if (tg == 0) ((float*)(ws + O_DEC))[(size_t)it * 128 + k] = __expf(tot);
    __syncthreads();
    const unsigned q_ = (lane & 15) >> 2, pp = lane & 3;
    const unsigned kbase = (unsigned)(size_t)sKt, vb0 = (unsigned)(size_t)sV;
    bf16x8 kf[2];
#pragma unroll
    for (int ks = 0; ks < 2; ++ks) { const unsigned R0 = 32 * ks + 8 * fq + q_;
        kf[ks] = tr_read2(kbase + offb(R0, 2 * wid + (pp >> 1)) + 8 * (pp & 1), kbase + offb(R0 + 4, 2 * wid + (pp >> 1)) + 8 * (pp & 1)); }
    float* DS = (float*)(ws + O_DS) + ((size_t)it * 128 + 16 * wid + fr) * 256 + 4 * fq;
#pragma unroll 4
    for (int vb = 0; vb < 16; ++vb) {
        const unsigned vbase = vb0 + (vb >> 3) * 16384; const int cb = vb & 7;
        f32x4 a = (f32x4){0.f, 0.f, 0.f, 0.f};
        { const unsigned R0 = 8 * fq + q_; bf16x8 v0, v1;
          tr_read2x2(vbase + offb(R0, 2 * cb + (pp >> 1)) + 8 * (pp & 1), vbase + offb(R0 + 4, 2 * cb + (pp >> 1)) + 8 * (pp & 1),
                     vbase + offb(R0 + 32, 2 * cb + (pp >> 1)) + 8 * (pp & 1), vbase + offb(R0 + 36, 2 * cb + (pp >> 1)) + 8 * (pp & 1), v0, v1);
          a = mfma16(v0, kf[0], a); a = mfma16(v1, kf[1], a); }
        *(f32x4*)(DS + 16 * vb) = a;
    }
}

__device__ __forceinline__ void gla_sample_item(const P& p, LAS unsigned char* lds, int it, int tid) {
    unsigned char* ws = p.ws;
    const int bs = it >> 3, h = (it >> 1) & 3, vh = it & 1;
    LAS float* sA = (LAS float*)lds;
    LAS float* sK = sA + 512;
    LAS float* sQ = sK + 512;
    LAS float* sRed = sQ + 512;
    const float* ACC1 = (const float*)(ws + O_ACC1); const float* rstd1 = (const float*)(ws + O_RSTD1);
    __syncthreads();
    { const int i = tid >> 7, k = tid & 127; const int row = TP + bs * 4 + i;
      const float* glr = (const float*)(ws + O_GLR) + (size_t)row * 16;
      float x = p.b_gk[h * 128 + k];
#pragma unroll
      for (int r = 0; r < 16; ++r) x += glr[r] * p.w_gk_up[r * 512 + h * 128 + k];
      sA[tid] = __expf(logsig(x) * (1.f / 16.f));
      const float rs = rstd1[row];
      sK[tid] = acc1_1(ACC1, bs * 4 + i, 512 + h * 128 + k) * rs;
      sQ[tid] = acc1_1(ACC1, bs * 4 + i, h * 128 + k) * rs * 0.08838834764831845f; }
    const int kq = tid >> 5, vc4 = tid & 31, v = vh * 128 + 4 * vc4;
    const float* s0 = p.state_gla + (((size_t)bs * 4 + h) * 128 + kq * 8) * 256 + v;
    f32x4 S[8];
#pragma unroll
    for (int kk = 0; kk < 8; ++kk) S[kk] = __builtin_nontemporal_load((const f32x4*)(s0 + (size_t)kk * 256));
    f32x4 vv[4];
#pragma unroll
    for (int i = 0; i < 4; ++i) vv[i] = acc1_4(ACC1, bs * 4 + i, 1024 + h * 256 + v) * rstd1[TP + bs * 4 + i];
    __syncthreads();
    float* GLAOS = (float*)(ws + O_GLAOS);
    LAS float* sRed4 = sRed;
#pragma unroll
    for (int i = 0; i < 4; ++i) {
        f32x4 po = (f32x4){0.f, 0.f, 0.f, 0.f};
#pragma unroll
        for (int kk = 0; kk < 8; ++kk) { const int k = kq * 8 + kk; S[kk] = S[kk] * sA[i * 128 + k] + vv[i] * sK[i * 128 + k]; po += S[kk] * sQ[i * 128 + k]; }
        *(LAS f32x4*)(sRed4 + (i * 16 + kq) * 128 + 4 * vc4) = po;
    }
    __syncthreads();
    { const int i = tid >> 7, vcol = tid & 127; float o = 0.f;
#pragma unroll
      for (int g2 = 0; g2 < 16; ++g2) o += sRed4[(i * 16 + g2) * 128 + vcol];
      GLAOS[(size_t)(bs * 4 + i) * 1024 + h * 256 + vh * 128 + vcol] = o; }
    float* so = p.out + OUT_GS + (((size_t)bs * 4 + h) * 128 + kq * 8) * 256 + v;
#pragma unroll
    for (int kk = 0; kk < 8; ++kk) __builtin_nontemporal_store(S[kk], (f32x4*)(so + (size_t)kk * 256));
}

__device__ __forceinline__ void phase3(const P& p, int tid, int G) {
    unsigned char* ws = p.ws;
    const int wave = tid >> 6, lane = tid & 63;
    bf16_t* CAT = (bf16_t*)(ws + O_CAT);
    {
        const float* DS = (const float*)(ws + O_DS); const float* DEC = (const float*)(ws + O_DEC); bf16_t* SC = (bf16_t*)(ws + O_SC);
        const bf16_t* OATT = (const bf16_t*)(ws + O_OATT); const float* LSE = (const float*)(ws + O_LSE);
        const int nscan = 8 * 128 * 128, stride_t = G * NTHR, stride_w = G * 8;
        int e2 = blockIdx.x * NTHR + tid, row = blockIdx.x * 8 + wave;
        while (e2 < nscan || row < TP) {
            const bool do_scan = e2 < nscan;
            const int bh = e2 >> 14, k = (e2 >> 7) & 127, v = (e2 & 127) * 2;
            f32x2 S = (f32x2){0.f, 0.f};
            for (int seg = 0; seg < 4; ++seg) {
                const bool do_row = row < TP;
                const int h = lane >> 3;
                float l0 = 0.f, l1 = 0.f, l2 = 0.f; u32x4 r[3][2];
                if (do_row) {
                    l0 = LSE[((size_t)0 * TP + row) * 8 + h]; l1 = LSE[((size_t)1 * TP + row) * 8 + h]; l2 = LSE[((size_t)2 * TP + row) * 8 + h];
#pragma unroll
                    for (int g = 0; g < 3; ++g) { const u32x4* src = (const u32x4*)(OATT + ((size_t)g * TP + row) * 1024 + 16 * lane);
                        r[g][0] = __builtin_nontemporal_load(src); r[g][1] = __builtin_nontemporal_load(src + 1); }
                }
                if (do_scan) {
#pragma unroll 8
                    for (int cc = 0; cc < 16; ++cc) {
                        const size_t it = (size_t)bh * 64 + seg * 16 + cc; const size_t o = (it * 128 + k) * 256 + v;
                        *(unsigned*)(SC + o) = cvt_pk_bf16(S[0], S[1]);
                        const float dec = DEC[it * 128 + k]; const f32x2 ds = __builtin_nontemporal_load((const f32x2*)(DS + o));
                        S = S * dec + ds;
                    }
                }
                if (do_row) {
                    const float mx = fmaxf(l0, fmaxf(l1, l2));
                    float w0 = fexp2(l0 - mx), w1 = fexp2(l1 - mx), w2 = fexp2(l2 - mx); const float inv = 1.f / (w0 + w1 + w2); w0 *= inv; w1 *= inv; w2 *= inv;
                    float o[16];
#pragma unroll
                    for (int e = 0; e < 16; ++e) o[e] = 0.f;
#pragma unroll
                    for (int g = 0; g < 3; ++g) { const float wg = g == 0 ? w0 : (g == 1 ? w1 : w2);
#pragma unroll
                        for (int hh = 0; hh < 2; ++hh) { const u32x4 q = r[g][hh];
                            o[8 * hh + 0] += wg * bflo(q.x); o[8 * hh + 1] += wg * bfhi(q.x); o[8 * hh + 2] += wg * bflo(q.y); o[8 * hh + 3] += wg * bfhi(q.y);
                            o[8 * hh + 4] += wg * bflo(q.z); o[8 * hh + 5] += wg * bfhi(q.z); o[8 * hh + 6] += wg * bflo(q.w); o[8 * hh + 7] += wg * bfhi(q.w); } }
                    float ss = 0.f;
#pragma unroll
                    for (int e = 0; e < 16; ++e) ss += o[e] * o[e];
                    ss = wave_sum(ss);
                    const float rs = rsqrtf(ss * (1.f / 1024.f) + EPS);
                    const f32x4* nw = (const f32x4*)(p.att_out_norm_w + 16 * lane);
                    u32x4* dst = (u32x4*)(CAT + (size_t)row * DM + 1024 + 16 * lane);
#pragma unroll
                    for (int hh = 0; hh < 2; ++hh) { const f32x4 n0 = nw[2 * hh], n1 = nw[2 * hh + 1]; u32x4 w;
                        w.x = cvt_pk_bf16(o[8 * hh + 0] * rs * n0[0], o[8 * hh + 1] * rs * n0[1]); w.y = cvt_pk_bf16(o[8 * hh + 2] * rs * n0[2], o[8 * hh + 3] * rs * n0[3]);
                        w.z = cvt_pk_bf16(o[8 * hh + 4] * rs * n1[0], o[8 * hh + 5] * rs * n1[1]); w.w = cvt_pk_bf16(o[8 * hh + 6] * rs * n1[2], o[8 * hh + 7] * rs * n1[3]);
                        dst[hh] = w; }
                    row += stride_w;
                }
            }
            if (do_scan) { *(f32x2*)(p.out + OUT_GP + ((size_t)bh * 128 + k) * 256 + v) = S; e2 += stride_t; }
        }
    }
    {
        const float* GLAOS = (const float*)(ws + O_GLAOS); const float* ATTS = (const float*)(ws + O_ATTS); const float* ACC1 = (const float*)(ws + O_ACC1);
        for (int s = blockIdx.x * 8 + wave; s < TS; s += G * 8) {
            const int row = TP + s; const float rs1 = ((const float*)(ws + O_RSTD1))[row];
            float o[16], a[16];
#pragma unroll
            for (int q4 = 0; q4 < 4; ++q4) { const f32x4 t = *(const f32x4*)(GLAOS + (size_t)s * 1024 + 16 * lane + 4 * q4), u = *(const f32x4*)(ATTS + (size_t)s * 1024 + 16 * lane + 4 * q4);
                o[4 * q4] = t[0]; o[4 * q4 + 1] = t[1]; o[4 * q4 + 2] = t[2]; o[4 * q4 + 3] = t[3]; a[4 * q4] = u[0]; a[4 * q4 + 1] = u[1]; a[4 * q4 + 2] = u[2]; a[4 * q4 + 3] = u[3]; }
            float sg = 0.f, sa = 0.f;
#pragma unroll
            for (int e = 0; e < 16; ++e) { sg += o[e] * o[e]; sa += a[e] * a[e]; }
            sg += __shfl_xor(sg, 1); sg += __shfl_xor(sg, 2); sg += __shfl_xor(sg, 4); sg += __shfl_xor(sg, 8);
            sa = wave_sum(sa);
            const float rg = rsqrtf(sg * (1.f / 256.f) + EPS), ra = rsqrtf(sa * (1.f / 1024.f) + EPS);
            const int vcol = (16 * lane) & 255;
            f32x4 g4[4];
#pragma unroll
            for (int q4 = 0; q4 < 4; ++q4) g4[q4] = acc1_4(ACC1, s, 2048 + 16 * lane + 4 * q4);
            asm volatile("" ::: "memory");
#pragma unroll
            for (int e = 0; e < 16; e += 2) {
                const f32x4 gr4 = g4[e >> 2];
                const float g0 = gr4[e & 2] * rs1, g1 = gr4[(e & 2) + 1] * rs1;
                const float y0 = o[e] * rg * p.gla_norm_w[vcol + e] * (g0 / (1.f + __expf(-g0))), y1 = o[e + 1] * rg * p.gla_norm_w[vcol + e + 1] * (g1 / (1.f + __expf(-g1)));
                *(unsigned*)(CAT + (size_t)row * DM + 16 * lane + e) = cvt_pk_bf16(y0, y1);
                const float z0 = a[e] * ra * p.att_out_norm_w[16 * lane + e], z1 = a[e + 1] * ra * p.att_out_norm_w[16 * lane + e + 1];
                *(unsigned*)(CAT + (size_t)row * DM + 1024 + 16 * lane + e) = cvt_pk_bf16(z0, z1);
            }
        }
    }
}

__device__ __forceinline__ void gla_c_item(const P& p, LAS unsigned char* lds, int it, int tid) {
    unsigned char* ws = p.ws;
    const int wid = tid >> 6, lane = tid & 63, fr = lane & 15, fq = lane >> 4;
    const int bh = it >> 6, c = it & 63, b = bh >> 2, h = bh & 3;
    const int row0 = b * SEQ + 64 * c;
    LAS unsigned char* sQ = lds;
    LAS unsigned char* sK = lds + 16384;
    LAS unsigned char* sV = lds + 32768;
    LAS unsigned char* sS = lds + 65536;
    LAS unsigned char* sA = lds + 131072;
    LAS float* sRed = (LAS float*)(lds + 139264);
    __syncthreads();
    const bf16_t* GV = (const bf16_t*)(ws + O_GV);
#pragma unroll
    for (int i = 0; i < 4; ++i) { const int q = tid + 512 * i, row = q >> 5, ch32 = q & 31;
        const u32x4 v = *(const u32x4*)(GV + (size_t)(row0 + row) * 1024 + h * 256 + ch32 * 8);
        *(LAS u32x4*)(sV + (ch32 >> 4) * 16384 + offb(row, ch32 & 15)) = v; }
    const bf16_t* SC = (const bf16_t*)(ws + O_SC) + (size_t)it * 128 * 256;
#pragma unroll
    for (int i = 0; i < 8; ++i) { const int q = tid + 512 * i, row = q >> 5, ch32 = q & 31;
        const u32x4 v = *(const u32x4*)(SC + (size_t)row * 256 + ch32 * 8);
        *(LAS u32x4*)(sS + (ch32 >> 4) * 32768 + offb(row, ch32 & 15)) = v; }
    const bf16_t* GQ = (const bf16_t*)(ws + O_GQ); const bf16_t* GK = (const bf16_t*)(ws + O_GK); const float* BCUM = (const float*)(ws + O_BCUM);
#pragma unroll
    for (int i = 0; i < 2; ++i) { const int q = tid + 512 * i, t = q >> 4, ch = q & 15;
        const size_t go = (size_t)(row0 + t) * 512 + h * 128 + ch * 8;
        const u32x4 qr = *(const u32x4*)(GQ + go), kr = *(const u32x4*)(GK + go);
        const f32x4 b0 = *(const f32x4*)(BCUM + go), b1 = *(const f32x4*)(BCUM + go + 4);
        float e[8], ie[8];
#pragma unroll
        for (int j = 0; j < 4; ++j) { e[j] = __expf(b0[j]); e[4 + j] = __expf(b1[j]); ie[j] = __expf(-b0[j]); ie[4 + j] = __expf(-b1[j]); }
        u32x4 qo, ko;
        qo.x = cvt_pk_bf16(bflo(qr.x) * e[0], bfhi(qr.x) * e[1]); qo.y = cvt_pk_bf16(bflo(qr.y) * e[2], bfhi(qr.y) * e[3]);
        qo.z = cvt_pk_bf16(bflo(qr.z) * e[4], bfhi(qr.z) * e[5]); qo.w = cvt_pk_bf16(bflo(qr.w) * e[6], bfhi(qr.w) * e[7]);
        ko.x = cvt_pk_bf16(bflo(kr.x) * ie[0], bfhi(kr.x) * ie[1]); ko.y = cvt_pk_bf16(bflo(kr.y) * ie[2], bfhi(kr.y) * ie[3]);
        ko.z = cvt_pk_bf16(bflo(kr.z) * ie[4], bfhi(kr.z) * ie[5]); ko.w = cvt_pk_bf16(bflo(kr.w) * ie[6], bfhi(kr.w) * ie[7]);
        *(LAS u32x4*)(sQ + offb(t, ch)) = qo; *(LAS u32x4*)(sK + offb(t, ch)) = ko; }
    __syncthreads();
    { const int tb = wid >> 1;
#pragma unroll
      for (int sbi = 0; sbi < 2; ++sbi) { const int sb = (wid & 1) * 2 + sbi;
          f32x4 a = (f32x4){0.f, 0.f, 0.f, 0.f};
          if (sb <= tb) {
#pragma unroll
              for (int ks = 0; ks < 4; ++ks) { const bf16x8 kf = *(const LAS bf16x8*)(sK + offb(16 * sb + fr, 4 * ks + fq)); const bf16x8 qf = *(const LAS bf16x8*)(sQ + offb(16 * tb + fr, 4 * ks + fq)); a = mfma16(kf, qf, a); }
          }
          const int t = 16 * tb + fr;
#pragma unroll
          for (int j = 0; j < 4; ++j) { const int s = 16 * sb + 4 * fq + j; if (s > t) a[j] = 0.f; }
          u32x2 w; w.x = cvt_pk_bf16(a[0], a[1]); w.y = cvt_pk_bf16(a[2], a[3]);
          *(LAS u32x2*)(sA + t * 128 + (16 * sb + 4 * fq) * 2) = w; } }
    __syncthreads();
    f32x4 acc[2][4];
#pragma unroll
    for (int vi = 0; vi < 2; ++vi)
#pragma unroll
        for (int tb = 0; tb < 4; ++tb) acc[vi][tb] = (f32x4){0.f, 0.f, 0.f, 0.f};
    const unsigned q_ = (lane & 15) >> 2, pp = lane & 3;
    const unsigned sbase = (unsigned)(size_t)sS, vbase0 = (unsigned)(size_t)sV;
#pragma unroll
    for (int ks = 0; ks < 4; ++ks) {
        bf16x8 qf[4];
#pragma unroll
        for (int tb = 0; tb < 4; ++tb) qf[tb] = *(const LAS bf16x8*)(sQ + offb(16 * tb + fr, 4 * ks + fq));
        { const int vb = 2 * wid; const unsigned base = sbase + (vb >> 3) * 32768; const int cb = vb & 7;
            const unsigned R0 = 32 * ks + 8 * fq + q_; bf16x8 s0, s1;
            tr_read2x2(base + offb(R0, 2 * cb + (pp >> 1)) + 8 * (pp & 1), base + offb(R0 + 4, 2 * cb + (pp >> 1)) + 8 * (pp & 1),
                       base + offb(R0, 2 * cb + 2 + (pp >> 1)) + 8 * (pp & 1), base + offb(R0 + 4, 2 * cb + 2 + (pp >> 1)) + 8 * (pp & 1), s0, s1);
#pragma unroll
            for (int tb = 0; tb < 4; ++tb) { acc[0][tb] = mfma16(s0, qf[tb], acc[0][tb]); acc[1][tb] = mfma16(s1, qf[tb], acc[1][tb]); } }
    }
#pragma unroll
    for (int ks = 0; ks < 2; ++ks) {
        bf16x8 af[4];
#pragma unroll
        for (int tb = 0; tb < 4; ++tb) af[tb] = *(const LAS bf16x8*)(sA + (16 * tb + fr) * 128 + (32 * ks + 8 * fq) * 2);
        { const int vb = 2 * wid; const unsigned base = vbase0 + (vb >> 3) * 16384; const int cb = vb & 7;
            const unsigned R0 = 32 * ks + 8 * fq + q_; bf16x8 v0, v1;
            tr_read2x2(base + offb(R0, 2 * cb + (pp >> 1)) + 8 * (pp & 1), base + offb(R0 + 4, 2 * cb + (pp >> 1)) + 8 * (pp & 1),
                       base + offb(R0, 2 * cb + 2 + (pp >> 1)) + 8 * (pp & 1), base + offb(R0 + 4, 2 * cb + 2 + (pp >> 1)) + 8 * (pp & 1), v0, v1);
#pragma unroll
            for (int tb = 0; tb < 4; ++tb) { acc[0][tb] = mfma16(v0, af[tb], acc[0][tb]); acc[1][tb] = mfma16(v1, af[tb], acc[1][tb]); } }
    }
#pragma unroll
    for (int tb = 0; tb < 4; ++tb) { float ss = 0.f;
#pragma unroll
        for (int vi = 0; vi < 2; ++vi)
#pragma unroll
            for (int j = 0; j < 4; ++j) ss += acc[vi][tb][j] * acc[vi][tb][j];
        ss += __shfl_xor(ss, 16); ss += __shfl_xor(ss, 32);
        if (fq == 0) sRed[wid * 64 + 16 * tb + fr] = ss; }
    __syncthreads();
    const bf16_t* GG = (const bf16_t*)(ws + O_GG); bf16_t* CAT = (bf16_t*)(ws + O_CAT);
#pragma unroll
    for (int tb = 0; tb < 4; ++tb) { const int t = 16 * tb + fr; float tot = 0.f;
#pragma unroll
        for (int w8 = 0; w8 < 8; ++w8) tot += sRed[w8 * 64 + t];
        const float rs = rsqrtf(tot * (1.f / 256.f) + EPS);
#pragma unroll
        for (int vi = 0; vi < 2; ++vi) { const int v = 16 * (2 * wid + vi) + 4 * fq;
            const u32x2 gr = *(const u32x2*)(GG + (size_t)(row0 + t) * 1024 + h * 256 + v);
            const f32x4 nw = *(const f32x4*)(p.gla_norm_w + v);
            const float g0 = bflo(gr.x), g1 = bfhi(gr.x), g2 = bflo(gr.y), g3 = bfhi(gr.y);
            const f32x4 a = acc[vi][tb] * rs * nw;
            u32x2 w; w.x = cvt_pk_bf16(a[0] * (g0 / (1.f + __expf(-g0))), a[1] * (g1 / (1.f + __expf(-g1)))); w.y = cvt_pk_bf16(a[2] * (g2 / (1.f + __expf(-g2))), a[3] * (g3 / (1.f + __expf(-g3))));
            *(u32x2*)(CAT + (size_t)(row0 + t) * DM + h * 256 + v) = w; } }
}

__device__ __forceinline__ void sample_fin_x1(const P& p, LAS unsigned char* lds, int tid, int G) {
    unsigned char* ws = p.ws;
    const int wave = tid >> 6, lane = tid & 63;
    LAS float* red = (LAS float*)lds;
    for (int s = blockIdx.x; s < TS; s += G) {
        const int row = TP + s, c = tid * 4;
        f32x4 v = *(const f32x4*)(p.x_sample + (size_t)s * DM + c);
#pragma unroll
        for (int kp = 0; kp < 8; ++kp) v += *(const f32x4*)((const float*)(ws + O_ACCO) + ((size_t)kp * TS + s) * DM + c);
        const float ss = wave_sum((v[0] * v[0] + v[1] * v[1]) + (v[2] * v[2] + v[3] * v[3]));
        __syncthreads();
        if (lane == 0) red[wave] = ss;
        __syncthreads();
        if (tid == 0) { float tot = 0.f;
#pragma unroll
            for (int w8 = 0; w8 < 8; ++w8) tot += red[w8];
            ((float*)(ws + O_SUMS))[row] = tot; }
        u32x2 w; w.x = cvt_pk_bf16(v[0], v[1]); w.y = cvt_pk_bf16(v[2], v[3]);
        *(u32x2*)((bf16_t*)(ws + O_X1B) + (size_t)row * DM + c) = w;
        *(f32x4*)((float*)(ws + O_X1) + (size_t)row * DM + c) = v;
    }
}
__device__ __forceinline__ void sample_fin_h(const P& p, int tid, int G) {
    unsigned char* ws = p.ws;
    const float* ACCU = (const float*)(ws + O_ACCU); const float* ss2 = (const float*)(ws + O_SUMS); bf16_t* HM = (bf16_t*)(ws + O_HM);
    for (int i = blockIdx.x * NTHR + tid; i < TS * DFF / 8; i += G * NTHR) {
        const int s = i >> 10, c = (i & 1023) * 8;
        const float rs = rsqrtf(ss2[TP + s] * (1.f / DM) + EPS);
        f32x4 a = *(const f32x4*)(ACCU + (size_t)s * DFF + c), b = *(const f32x4*)(ACCU + (size_t)s * DFF + c + 4);
#pragma unroll
        for (int kp = 1; kp < 8; ++kp) { a += *(const f32x4*)(ACCU + ((size_t)kp * TS + s) * DFF + c); b += *(const f32x4*)(ACCU + ((size_t)kp * TS + s) * DFF + c + 4); }
        a = a * rs; b = b * rs;
#pragma unroll
        for (int j = 0; j < 4; ++j) { a[j] = fmaxf(a[j], 0.f); a[j] *= a[j]; b[j] = fmaxf(b[j], 0.f); b[j] *= b[j]; }
        u32x4 w; w.x = cvt_pk_bf16(a[0], a[1]); w.y = cvt_pk_bf16(a[2], a[3]); w.z = cvt_pk_bf16(b[0], b[1]); w.w = cvt_pk_bf16(b[2], b[3]);
        *(u32x4*)(HM + (size_t)(TP + s) * DFF + c) = w;
    }
}

__device__ __forceinline__ void phase8(const P& p, int tid, int base, int cnt) {
    const int wave = tid >> 6, lane = tid & 63;
    const bf16_t* X2B = (const bf16_t*)(p.ws + O_CAT);
    const int m1 = base + cnt;
    for (int mb = base + wave; mb < m1; mb += 32) {
        u32x4 raw[4][4];
#pragma unroll
        for (int q = 0; q < 4; ++q) { const int m = mb + q * 8;
            if (m < m1) { const u32x4* xr = (const u32x4*)(X2B + (size_t)m * DM);
#pragma unroll
                for (int j = 0; j < 4; ++j) raw[q][j] = __builtin_nontemporal_load(xr + lane + 64 * j); } }
        asm volatile("" ::: "memory");
#pragma unroll
        for (int q = 0; q < 4; ++q) { const int m = mb + q * 8;
            if (m < m1) {
                float v[32]; float s = 0.f;
#pragma unroll
                for (int j = 0; j < 4; ++j) { const u32x4 r = raw[q][j];
                    v[8 * j + 0] = bflo(r.x); v[8 * j + 1] = bfhi(r.x); v[8 * j + 2] = bflo(r.y); v[8 * j + 3] = bfhi(r.y);
                    v[8 * j + 4] = bflo(r.z); v[8 * j + 5] = bfhi(r.z); v[8 * j + 6] = bflo(r.w); v[8 * j + 7] = bfhi(r.w); }
#pragma unroll
                for (int e = 0; e < 32; ++e) s += v[e] * v[e];
                s = wave_sum(s);
                const float rs = rsqrtf(s * (1.f / DM) + EPS);
                float* yr = p.out + OUT_YP + (size_t)m * DM;
#pragma unroll
                for (int j = 0; j < 4; ++j) { const int c = (lane + 64 * j) * 8;
                    const f32x4 w0 = *(const f32x4*)(p.final_norm_w + c), w1 = *(const f32x4*)(p.final_norm_w + c + 4);
                    __builtin_nontemporal_store((f32x4){v[8 * j] * rs * w0[0], v[8 * j + 1] * rs * w0[1], v[8 * j + 2] * rs * w0[2], v[8 * j + 3] * rs * w0[3]}, (f32x4*)(yr + c));
                    __builtin_nontemporal_store((f32x4){v[8 * j + 4] * rs * w1[0], v[8 * j + 5] * rs * w1[1], v[8 * j + 6] * rs * w1[2], v[8 * j + 7] * rs * w1[3]}, (f32x4*)(yr + c + 4)); }
            } }
    }
}

#define XB_TMO      128
#define XB_XCNT(j)  (256  + 64 * (j))
#define XB_XSUB(j)  (1280 + 64 * (j))
#define XB_XGEN(j)  (2304 + 64 * (j))
#define XB_TOP      3328
#define XB_TOPGEN   3392
#define XCD_BAR_WORDS 3456
#define XB_SPIN_CAP (1u << 18)
__device__ __forceinline__ unsigned xb_ld(unsigned* p)              { return __hip_atomic_load(p, __ATOMIC_RELAXED, __HIP_MEMORY_SCOPE_AGENT); }
__device__ __forceinline__ unsigned xb_add(unsigned* p, unsigned v) { return __hip_atomic_fetch_add(p, v, __ATOMIC_RELAXED, __HIP_MEMORY_SCOPE_AGENT); }
__device__ __forceinline__ unsigned xb_xcc_id() { return (unsigned)__builtin_amdgcn_s_getreg((3 << 11) | 20) & 0xFu; }
#define XB_SPIN(cond, bar) do { unsigned _sp = 0; while (cond) { __builtin_amdgcn_s_sleep(1); \
    if ((++_sp & 255u) == 0u) { if (xb_ld(&(bar)[XB_TMO])) break; if (_sp > XB_SPIN_CAP) { atomicAdd(&(bar)[XB_TMO], 1u); break; } } } } while (0)
struct XcdBarrier { unsigned* bar; unsigned x; volatile LAS unsigned* st; };
__device__ __forceinline__ XcdBarrier xcd_barrier_post(unsigned* bar, volatile LAS unsigned* st) {
    XcdBarrier b; b.bar = bar; b.x = xb_xcc_id(); b.st = st;
    if (threadIdx.x == 0) (void)xb_add(&bar[XB_XCNT(b.x)], 1u);
    return b;
}
__device__ __forceinline__ void xcd_barrier_complete(unsigned* bar, unsigned x, unsigned& nloc, unsigned& nx) {
    const unsigned G = gridDim.x * gridDim.y * gridDim.z;
    unsigned sum, cnt, mine, sp = 0u;
    for (;;) {
        sum = 0u; cnt = 0u; mine = 0u;
#pragma unroll
        for (unsigned j = 0; j < 16; ++j) { const unsigned c = xb_ld(&bar[XB_XCNT(j)]); sum += c; cnt += (c > 0u) ? 1u : 0u; mine = (j == x) ? c : mine; }
        if (sum == G) break;
        __builtin_amdgcn_s_sleep(1);
        if ((++sp & 255u) == 0u) { if (xb_ld(&bar[XB_TMO])) break; if (sp > XB_SPIN_CAP) { atomicAdd(&bar[XB_TMO], 1u); break; } }
    }
    nloc = mine > 0u ? mine : 1u; nx = cnt > 0u ? cnt : 1u;
}
__device__ __forceinline__ void xcd_barrier(const XcdBarrier& b) {
    asm volatile("s_waitcnt vmcnt(0)" ::: "memory");
    __syncthreads();
    if (threadIdx.x == 0) {
        unsigned* bar = b.bar;
        __builtin_amdgcn_s_waitcnt(0);
        unsigned nloc = b.st[0], nx = b.st[1];
        if (nloc == 0u) { xcd_barrier_complete(bar, b.x, nloc, nx); b.st[0] = nloc; b.st[1] = nx; }
        const unsigned old = xb_add(&bar[XB_XSUB(b.x)], 1u);
        const unsigned gen = old / nloc;
        if (old + 1u == (gen + 1u) * nloc) {
            __builtin_amdgcn_fence(__ATOMIC_RELEASE, "agent");
            asm volatile("s_waitcnt vmcnt(0)" ::: "memory");
            const unsigned og = xb_add(&bar[XB_TOP], 1u);
            const unsigned tg = og / nx;
            if (og + 1u == (tg + 1u) * nx) xb_add(&bar[XB_TOPGEN], 1u);
            else XB_SPIN(xb_ld(&bar[XB_TOPGEN]) == tg, bar);
            __builtin_amdgcn_fence(__ATOMIC_ACQUIRE, "agent");
            xb_add(&bar[XB_XGEN(b.x)], 1u);
            asm volatile("s_waitcnt vmcnt(0)" ::: "memory");
        } else {
            XB_SPIN(xb_ld(&bar[XB_XGEN(b.x)]) == gen, bar);
            __builtin_amdgcn_fence(__ATOMIC_ACQUIRE, "agent");
            asm volatile("s_waitcnt vmcnt(0)" ::: "memory");
        }
    }
    __syncthreads();
}

__global__ void __launch_bounds__(NTHR) fwd_megakernel(P p) {
    extern __shared__ __attribute__((aligned(16))) unsigned char smem[];
    LAS unsigned char* lds = (LAS unsigned char*)smem;
    cg::grid_group grid = cg::this_grid();
    const int G = gridDim.x;
    unsigned char* ws = p.ws;
    if (threadIdx.x < 4) ((LAS unsigned*)(lds + LDS_BYTES - 16))[threadIdx.x] = 0u;
    __syncthreads();
    XcdBarrier xbar = xcd_barrier_post((unsigned*)(ws + O_BAR), (volatile LAS unsigned*)(lds + LDS_BYTES - 16));
    if (p.ws == nullptr) grid.sync();
#define GRID_SYNC() xcd_barrier(xbar)

    for (int rep = 0; rep < NREP(1); ++rep) { phase0(p, lds, fresh_tid(), G); __syncthreads(); }
    GRID_SYNC();

    {
        pg8::StaticOrder S; S.init((const bf16_t*)(ws + O_XB), (const bf16_t*)(ws + O_BT1), TP, N1, DM, G, (int)blockIdx.x);
        pg8::PieceOrder SP; SP.init((const bf16_t*)(ws + O_XB) + (size_t)TP * DM, (const bf16_t*)(ws + O_BT1), N1, DM, 256, G, (int)blockIdx.x);
        pg8::CombOrder SC; SC.init(S, SP, DM / 64, 4);
        EpiBoth<Epi1> E{Epi1{p}, EpiPartP{(float*)(ws + O_ACC1), N1}};
        pg8::gemm_phase<EpiBoth<Epi1>, pg8::CombOrder>(lds, pg8::Gemm{DM, DM / 64}, SC, E);
        for (int rep = 0; rep < NREP(4); ++rep) phase1_skinny(p, lds, fresh_tid(), G);
    }
    GRID_SYNC();

    {
        { const int t0 = fresh_tid(); const int w = __builtin_amdgcn_readfirstlane(t0 >> 6);
          __syncthreads();
          if (w < 4) { for (int wi = w * G + blockIdx.x; wi < 1024; wi += G * 4) attn_sample_item(p, wi, t0 & 63); }
          else side_transposes(p, lds, w - 4, t0 & 63, G); }
        for (int rep = 0; rep < NREP(16); ++rep) { const int t0 = fresh_tid(); for (int it = blockIdx.x; it < 256; it += G) gla_sample_item(p, lds, it, t0); }
        for (int rep = 0; rep < NREP(32); ++rep) { const int t0 = fresh_tid(); for (int it = blockIdx.x; it < 512; it += G) gla_a_item(p, lds, it, t0); }
        for (int rep = 0; rep < NREP(64); ++rep) attn_prompt_loop(p, lds, fresh_tid(), G);
    }
    GRID_SYNC();

    for (int rep = 0; rep < NREP(128); ++rep) phase3(p, fresh_tid(), G);
    GRID_SYNC();

    for (int rep = 0; rep < NREP(256); ++rep) { const int t0 = fresh_tid(); for (int it = blockIdx.x; it < 512; it += G) gla_c_item(p, lds, it, t0); }
    __syncthreads();
    {
        pg8::PieceOrder SP; SP.init((const bf16_t*)(ws + O_CAT) + (size_t)TP * DM, (const bf16_t*)(ws + O_BTO), DM, DM, 256, G, (int)blockIdx.x);
        EpiPart EA{(float*)(ws + O_ACCO), DM};
        pg8::gemm_phase<EpiPart, pg8::PieceOrder>(lds, pg8::Gemm{DM, 4}, SP, EA);
    }
    GRID_SYNC();

    {
        pg8::StaticOrder S; S.init((const bf16_t*)(ws + O_CAT), (const bf16_t*)(ws + O_BTO), TP, DM, DM, G, (int)blockIdx.x);
        EpiO E{p};
        pg8::gemm_phase<EpiO, pg8::StaticOrder>(lds, pg8::Gemm{DM, DM / 64}, S, E);
        sample_fin_x1(p, lds, fresh_tid(), G);
    }
    GRID_SYNC();

    {
        pg8::StaticOrder S; S.init((const bf16_t*)(ws + O_X1B), (const bf16_t*)(ws + O_BTU), TP, DFF, DM, G, (int)blockIdx.x);
        pg8::PieceOrder SP; SP.init((const bf16_t*)(ws + O_X1B) + (size_t)TP * DM, (const bf16_t*)(ws + O_BTU), DFF, DM, 256, G, (int)blockIdx.x);
        pg8::CombOrder SC; SC.init(S, SP, DM / 64, 4);
        EpiBoth<EpiU> E{EpiU{p}, EpiPartP{(float*)(ws + O_ACCU), DFF}};
        pg8::gemm_phase<EpiBoth<EpiU>, pg8::CombOrder>(lds, pg8::Gemm{DM, DM / 64}, SC, E);
    }
    GRID_SYNC();

    {
        pg8::StaticOrder S; S.init((const bf16_t*)(ws + O_HM), (const bf16_t*)(ws + O_BTD), TP, DM, DFF, G, (int)blockIdx.x);
        EpiD E{p};
        for (int rep = 0; rep < NREP(2048); ++rep) pg8::gemm_phase<EpiD, pg8::StaticOrder>(lds, pg8::Gemm{DFF, DFF / 64}, S, E);
        sample_fin_h(p, fresh_tid(), G);
    }
    GRID_SYNC();

    {
        pg8::PieceOrder SP; SP.init((const bf16_t*)(ws + O_HM) + (size_t)TP * DFF, (const bf16_t*)(ws + O_BTD), DM, DFF, 512, G, (int)blockIdx.x);
        EpiPart EA{(float*)(ws + O_ACCD), DM};
        pg8::gemm_phase<EpiPart, pg8::PieceOrder>(lds, pg8::Gemm{DFF, 8}, SP, EA);
        int base, cnt; const int c = (int)blockIdx.x;
        if (G == 256) { if (c < 128) { base = c * 20; cnt = 20; } else { base = 2560 + (c - 128) * 44; cnt = 44; } }
        else { const int per = (TP + G - 1) / G; base = c * per; cnt = base + per <= TP ? per : (TP > base ? TP - base : 0); }
        phase8(p, fresh_tid(), base, cnt);
    }
    GRID_SYNC();

    if (REP_MASK & 4096) { for (int rep = 0; rep < 10; ++rep) GRID_SYNC(); }
    {
        const int tid = fresh_tid(), wave = tid >> 6, lane = tid & 63;
        LAS float* red = (LAS float*)lds;
        for (int s = blockIdx.x; s < TS; s += G) {
            const int c = tid * 4;
            f32x4 v = *(const f32x4*)((const float*)(ws + O_X1) + (size_t)(TP + s) * DM + c);
#pragma unroll
            for (int kp = 0; kp < 16; ++kp) v += *(const f32x4*)((const float*)(ws + O_ACCD) + ((size_t)kp * TS + s) * DM + c);
            float ss = wave_sum((v[0] * v[0] + v[1] * v[1]) + (v[2] * v[2] + v[3] * v[3]));
            __syncthreads();
            if (lane == 0) red[wave] = ss;
            __syncthreads();
            float tot = 0.f;
#pragma unroll
            for (int w8 = 0; w8 < 8; ++w8) tot += red[w8];
            const float rs = rsqrtf(tot * (1.f / DM) + EPS);
            *(f32x4*)(p.out + OUT_YS + (size_t)s * DM + c) = v * rs * *(const f32x4*)(p.final_norm_w + c);
        }
    }
}

extern "C" void kernel_launch(void* const* d_in, const int* in_sizes, int n_in, void* d_out, int out_size, void* d_ws, size_t ws_size, hipStream_t stream) {
    static int grid_blocks = 0;
    if (!grid_blocks) {
        int dev = 0, cus = 0, per_cu = 0;
        hipGetDevice(&dev);
        hipDeviceGetAttribute(&cus, hipDeviceAttributeMultiprocessorCount, dev);
        hipFuncSetAttribute((const void*)fwd_megakernel, hipFuncAttributeMaxDynamicSharedMemorySize, LDS_BYTES);
        hipOccupancyMaxActiveBlocksPerMultiprocessor(&per_cu, (const void*)fwd_megakernel, NTHR, LDS_BYTES);
        if (per_cu < 1) per_cu = 1;
        grid_blocks = cus * per_cu;
        if (ws_size < WS_END) fprintf(stderr, "workspace too small: %zu < %zu\n", ws_size, (size_t)WS_END);
    }
    P p{};
    p.x_prompt = (const float*)d_in[0]; p.x_sample = (const float*)d_in[1]; p.cache_k = (const float*)d_in[2]; p.cache_v = (const float*)d_in[3];
    p.state_gla = (const float*)d_in[4]; p.attn_norm_w = (const float*)d_in[5]; p.w_in = (const float*)d_in[6]; p.w_gk_up = (const float*)d_in[7];
    p.b_gk = (const float*)d_in[8]; p.gla_norm_w = (const float*)d_in[9]; p.att_out_norm_w = (const float*)d_in[10]; p.w_out = (const float*)d_in[11];
    p.ffn_norm_w = (const float*)d_in[12]; p.w_up = (const float*)d_in[13]; p.w_down = (const float*)d_in[14]; p.final_norm_w = (const float*)d_in[15];
    p.out = (float*)d_out; p.ws = (unsigned char*)d_ws;
    hipMemsetAsync((char*)d_ws + O_BAR, 0, 16384, stream);
    void* args[] = {&p};
    hipError_t e = hipLaunchCooperativeKernel((const void*)fwd_megakernel, dim3(grid_blocks), dim3(NTHR), args, LDS_BYTES, stream);
    if (e != hipSuccess) fprintf(stderr, "cooperative launch failed: %s (grid %d)\n", hipGetErrorString(e), grid_blocks);
}
```

```cpp
#include <hip/hip_runtime.h>
#include <hip/hip_cooperative_groups.h>
#include <cstdio>
namespace cg = cooperative_groups;

#define LAS __attribute__((address_space(3)))
typedef unsigned short bf16_t;
typedef short bf16x8 __attribute__((ext_vector_type(8)));
typedef float f32x4 __attribute__((ext_vector_type(4)));
typedef float f32x2 __attribute__((ext_vector_type(2)));
typedef unsigned u32x4 __attribute__((ext_vector_type(4)));
typedef unsigned u32x2 __attribute__((ext_vector_type(2)));

constexpr int DM = 2048, TP = 8192, TS = 128, MT = TP + TS, SEQ = 4096, DFF = 8192;
constexpr int N1 = 6144;
constexpr float EPS = 1e-6f;
constexpr float LOG2E = 1.4426950408889634f;
constexpr int NTHR = 512;
constexpr int LDS_BYTES = 147456;
#ifndef PH_MASK
#define PH_MASK 0x1ff
#endif
#ifndef REP_MASK
#define REP_MASK 0
#endif
#define NREP(b) ((REP_MASK & (b)) ? 2 : 1)

constexpr size_t OUT_YP = 0, OUT_YS = 16777216, OUT_KW = 17039360, OUT_VW = 21233664, OUT_GP = 25427968,
                 OUT_KN = 25690112, OUT_VN = 25821184, OUT_GS = 25952256;

constexpr size_t al(size_t x) { return (x + 255) & ~(size_t)255; }
constexpr size_t O_BAR = 0;
constexpr size_t O_SUMS = 16384;
constexpr size_t O_RSTD1 = O_SUMS + al((size_t)MT * 4);
constexpr size_t O_GLR = O_RSTD1 + al((size_t)MT * 4);
constexpr size_t O_XB = O_GLR + al((size_t)MT * 16 * 4);
constexpr size_t O_BT1 = O_XB + al((size_t)MT * DM * 2);
constexpr size_t O_BTG = O_BT1 + al((size_t)N1 * DM * 2);
constexpr size_t O_BTO = O_BTG + al((size_t)16 * DM * 2);
constexpr size_t O_BTU = O_BTO + al((size_t)DM * DM * 2);
constexpr size_t O_BTD = O_BTU + al((size_t)DFF * DM * 2);
constexpr size_t O_GQ = O_BTD + al((size_t)DM * DFF * 2);
constexpr size_t O_GK = O_GQ + al((size_t)MT * 512 * 2);
constexpr size_t O_GV = O_GK + al((size_t)MT * 512 * 2);
constexpr size_t O_GG = O_GV + al((size_t)MT * 1024 * 2);
constexpr size_t O_AQ = O_GG + al((size_t)MT * 1024 * 2);
constexpr size_t O_AK = O_AQ + al((size_t)MT * 1024 * 2);
constexpr size_t O_AV = O_AK + al((size_t)MT * 1024 * 2);
constexpr size_t O_BCUM = O_AV + al((size_t)MT * 1024 * 2);
constexpr size_t O_DS = O_BCUM + al((size_t)TP * 512 * 4);
constexpr size_t O_SC = O_DS + al((size_t)512 * 128 * 256 * 4);
constexpr size_t O_DEC = O_SC + al((size_t)512 * 128 * 256 * 2);
constexpr size_t O_OATT = O_DEC + al((size_t)512 * 128 * 4);
constexpr size_t O_LSE = O_OATT + al((size_t)3 * TP * 1024 * 2);
constexpr size_t O_ATTS = O_LSE + al((size_t)3 * TP * 8 * 4);
constexpr size_t O_GLAOS = O_ATTS + al((size_t)TS * 1024 * 4);
constexpr size_t O_CAT = O_GLAOS + al((size_t)TS * 1024 * 4);
constexpr size_t O_X1 = O_CAT + al((size_t)MT * DM * 2);
constexpr size_t O_X1B = O_X1 + al((size_t)MT * DM * 4);
constexpr size_t O_HM = O_X1B + al((size_t)MT * DM * 2);
constexpr size_t O_ACC1 = O_HM + al((size_t)MT * DFF * 2);
constexpr size_t O_ACCO = O_ACC1 + al((size_t)8 * TS * N1 * 4);
constexpr size_t O_ACCU = O_ACCO + al((size_t)8 * TS * DM * 4);
constexpr size_t O_ACCD = O_ACCU + al((size_t)8 * TS * DFF * 4);
constexpr size_t WS_END = O_ACCD + al((size_t)32 * TS * DM * 4) + (size_t)4 * 1024 * 1024;
__device__ __forceinline__ f32x4 acc1_4(const float* ACC1, int srow, int col) {
    f32x4 s = *(const f32x4*)(ACC1 + (size_t)srow * N1 + col);
#pragma unroll
    for (int kp = 1; kp < 8; ++kp) s += *(const f32x4*)(ACC1 + ((size_t)kp * TS + srow) * N1 + col);
    return s;
}
__device__ __forceinline__ float acc1_1(const float* ACC1, int srow, int col) {
    float s = ACC1[(size_t)srow * N1 + col];
#pragma unroll
    for (int kp = 1; kp < 8; ++kp) s += ACC1[((size_t)kp * TS + srow) * N1 + col];
    return s;
}

struct P {
    const float *x_prompt, *x_sample, *cache_k, *cache_v, *state_gla, *attn_norm_w, *w_in, *w_gk_up, *b_gk, *gla_norm_w,
        *att_out_norm_w, *w_out, *ffn_norm_w, *w_up, *w_down, *final_norm_w;
    float* out;
    unsigned char* ws;
};

__device__ __forceinline__ unsigned cvt_pk_bf16(float lo, float hi) { unsigned r; asm volatile("v_cvt_pk_bf16_f32 %0, %1, %2" : "=v"(r) : "v"(lo), "v"(hi)); return r; }
__device__ __forceinline__ bf16_t f2bf(float f) { return (bf16_t)(cvt_pk_bf16(f, 0.f) & 0xffffu); }
__device__ __forceinline__ float bflo(unsigned u) { return __uint_as_float(u << 16); }
__device__ __forceinline__ float bfhi(unsigned u) { return __uint_as_float(u & 0xffff0000u); }
__device__ __forceinline__ float bf2f(bf16_t b) { return __uint_as_float(((unsigned)b) << 16); }
__device__ __forceinline__ float wave_sum(float v) {
#pragma unroll
    for (int o = 1; o < 64; o <<= 1) v += __shfl_xor(v, o);
    return v;
}
__device__ __forceinline__ int fresh_tid() { int t = threadIdx.x; asm volatile("" : "+v"(t)); return t; }
__device__ __forceinline__ float fexp2(float x) { return __builtin_amdgcn_exp2f(x); }
__device__ __forceinline__ float flog2(float x) { return __builtin_amdgcn_logf(x); }
__device__ __forceinline__ unsigned offb(unsigned row, unsigned ch) { return 256u * row + 16u * (ch ^ (((row & 3u) << 2) | ((row >> 2) & 3u))); }
__device__ __forceinline__ bf16x8 tr_read2(unsigned a0, unsigned a1) {
    u32x2 r0, r1;
    asm volatile("ds_read_b64_tr_b16 %0, %2\n\tds_read_b64_tr_b16 %1, %3\n\ts_waitcnt lgkmcnt(0)" : "=&v"(r0), "=&v"(r1) : "v"(a0), "v"(a1) : "memory");
    u32x4 r; r.x = r0.x; r.y = r0.y; r.z = r1.x; r.w = r1.y;
    return __builtin_bit_cast(bf16x8, r);
}
__device__ __forceinline__ void tr_read_4x2(const unsigned (&a)[4], bf16x8 (&out)[4]) {
    u32x2 r[8];
    asm volatile(
        "ds_read_b64_tr_b16 %0, %8\n\tds_read_b64_tr_b16 %1, %8 offset:4096\n\t"
        "ds_read_b64_tr_b16 %2, %9\n\tds_read_b64_tr_b16 %3, %9 offset:4096\n\t"
        "ds_read_b64_tr_b16 %4, %10\n\tds_read_b64_tr_b16 %5, %10 offset:4096\n\t"
        "ds_read_b64_tr_b16 %6, %11\n\tds_read_b64_tr_b16 %7, %11 offset:4096\n\t"
        "s_waitcnt lgkmcnt(0)"
        : "=&v"(r[0]), "=&v"(r[1]), "=&v"(r[2]), "=&v"(r[3]), "=&v"(r[4]), "=&v"(r[5]), "=&v"(r[6]), "=&v"(r[7])
        : "v"(a[0]), "v"(a[1]), "v"(a[2]), "v"(a[3])
        : "memory");
#pragma unroll
    for (int i = 0; i < 4; ++i) { u32x4 t; t.x = r[2 * i].x; t.y = r[2 * i].y; t.z = r[2 * i + 1].x; t.w = r[2 * i + 1].y; out[i] = __builtin_bit_cast(bf16x8, t); }
}
__device__ __forceinline__ void tr_read2x2(unsigned a0, unsigned a1, unsigned b0, unsigned b1, bf16x8& fa, bf16x8& fb) {
    u32x2 r0, r1, r2, r3;
    asm volatile("ds_read_b64_tr_b16 %0, %4\n\tds_read_b64_tr_b16 %1, %5\n\tds_read_b64_tr_b16 %2, %6\n\tds_read_b64_tr_b16 %3, %7\n\ts_waitcnt lgkmcnt(0)"
                 : "=&v"(r0), "=&v"(r1), "=&v"(r2), "=&v"(r3) : "v"(a0), "v"(a1), "v"(b0), "v"(b1) : "memory");
    u32x4 x; x.x = r0.x; x.y = r0.y; x.z = r1.x; x.w = r1.y; fa = __builtin_bit_cast(bf16x8, x);
    u32x4 y; y.x = r2.x; y.y = r2.y; y.z = r3.x; y.w = r3.y; fb = __builtin_bit_cast(bf16x8, y);
}
__device__ __forceinline__ bf16x8 pack8(f32x4 a, f32x4 b) {
    u32x4 r; r.x = cvt_pk_bf16(a[0], a[1]); r.y = cvt_pk_bf16(a[2], a[3]); r.z = cvt_pk_bf16(b[0], b[1]); r.w = cvt_pk_bf16(b[2], b[3]);
    return __builtin_bit_cast(bf16x8, r);
}
__device__ __forceinline__ f32x4 mfma16(bf16x8 a, bf16x8 b, f32x4 c) { return __builtin_amdgcn_mfma_f32_16x16x32_bf16(a, b, c, 0, 0, 0); }

namespace pg8 {
constexpr int BM = 256, BK = 64, HALF = 128, HTB = HALF * BK * 2, STAGE_BYTES = 8 * HTB, NXCD = 8, WGM = 8;
__host__ __device__ __forceinline__ int lds_byte(int r, int c) { const int st = (r >> 4) * 2 + (c >> 5), rr = r & 15, cc = c & 31, ob = rr * 64 + cc * 2; return st * 1024 + (ob ^ (((ob >> 9) & 1) << 5)); }
__host__ __device__ __forceinline__ void stage_rc(int b, int& R, int& C) { const int st = b / 1024, sb = b % 1024, swz = sb ^ (((sb >> 9) & 1) << 5); R = (st >> 1) * 16 + swz / 64; C = (st & 1) * 32 + (swz % 64) / 2; }
__host__ __device__ __forceinline__ int perm32(int rho) { const int n = rho >> 4, i = rho & 15; return 8 * (i >> 2) + 4 * n + (i & 3); }
struct Unit { int pm, pn; const char* A; const char* B; int nt, kind; };
struct Gemm { int ld, nt; };
struct StaticOrder {
    int nM, nN, nwg, G, c; const char* Ab; const char* Bb; size_t tstep;
    __device__ void init(const bf16_t* A, const bf16_t* Bt, int M, int N, int ld, int G_, int c_) { nM = M / BM; nN = N / BM; nwg = nM * nN; G = G_; c = c_; Ab = (const char*)A; Bb = (const char*)Bt; tstep = (size_t)BM * ld * 2; }
    __device__ bool next(int i, Unit& u) const {
        const long L = (long)i * G + c; if (L >= nwg) return false;
        int wgid = (int)L; { const int q = nwg / NXCD, r = nwg % NXCD, xcd = wgid % NXCD, off = wgid / NXCD; wgid = (xcd < r ? xcd * (q + 1) : r * (q + 1) + (xcd - r) * q) + off; }
        const int nig = WGM * nN, gid = wgid / nig, fm = gid * WGM, gsz = (nM - fm) < WGM ? (nM - fm) : WGM;
        u.pm = fm + ((wgid % nig) % gsz); u.pn = (wgid % nig) / gsz; u.A = Ab + (size_t)u.pm * tstep; u.B = Bb + (size_t)u.pn * tstep; u.nt = 0; u.kind = 0; return true;
    }
};
struct PieceOrder {
    int nN, nK, G, c; const char* Ab; const char* Bb; size_t tstep, kbytes;
    __device__ void init(const bf16_t* A, const bf16_t* Bt, int N, int ld, int klen, int G_, int c_) { nN = N / BM; nK = ld / klen; G = G_; c = c_; Ab = (const char*)A; Bb = (const char*)Bt; tstep = (size_t)BM * ld * 2; kbytes = (size_t)klen * 2; }
    __device__ bool next(int i, Unit& u) const {
        const int L = i * G + c; if (L >= nN * nK) return false;
        u.pn = L % nN; u.pm = L / nN; u.A = Ab + (size_t)u.pm * kbytes; u.B = Bb + (size_t)u.pn * tstep + (size_t)u.pm * kbytes; u.nt = 0; u.kind = 1; return true;
    }
};

struct CombOrder {
    StaticOrder s; PieceOrder p; int ns, nt_full, nt_piece;
    __device__ void init(const StaticOrder& s_, const PieceOrder& p_, int nt_full_, int nt_piece_) { s = s_; p = p_; nt_full = nt_full_; nt_piece = nt_piece_; ns = s.c < s.nwg ? (s.nwg - 1 - s.c) / s.G + 1 : 0; }
    __device__ bool next(int i, Unit& u) const {
        if (i < ns) { s.next(i, u); u.nt = nt_full; return true; }
        if (p.next(i - ns, u)) { u.nt = nt_piece; return true; }
        return false;
    }
};

template <class Epi, class Sched>
__device__ __forceinline__ void gemm_phase(LAS unsigned char* lds, const Gemm g, const Sched& S, const Epi& E) {
    const int tid = fresh_tid(), wid = __builtin_amdgcn_readfirstlane(tid >> 6), lane = tid & 63, wr = wid >> 2, wc = wid & 3, fr = lane & 15, fq = lane >> 4;
    const int K = g.ld;
    unsigned voffA[2], voffB[2];
#pragma unroll
    for (int i = 0; i < 2; ++i) { int R, C; stage_rc(tid * 16 + i * 8192, R, C); const int Rb = Epi::PERM ? ((R & ~31) + perm32(R & 31)) : R;
        voffA[i] = (unsigned)(R * K + C) * 2u; voffB[i] = (unsigned)(Rb * K + C) * 2u; }
    const size_t kstep = (size_t)(BK * 2);
    const size_t hstep = (size_t)HALF * K * 2;
    const unsigned ldsw = (unsigned)wid * 1024u;
    const int aoff = lds_byte(wr * 64 + fr, fq * 8), boff = lds_byte(wc * 32 + fr, fq * 8);
#define PG8_SA(b, h) (((b) * 2 + (h)) * HTB)
#define PG8_SB(b, h) ((4 + (b) * 2 + (h)) * HTB)
#define PG8_STAGE(bufoff, gbase, voff) do { _Pragma("unroll") for (int _i = 0; _i < 2; ++_i) \
        __builtin_amdgcn_global_load_lds((const unsigned*)((const char*)(gbase) + (voff)[_i]), (LAS unsigned*)(lds + (bufoff) + ldsw + _i * 8192), 16, 0, 0); } while (0)
#define PG8_LDA(dst, b, h) do { _Pragma("unroll") for (int m = 0; m < 4; ++m) _Pragma("unroll") for (int k = 0; k < 2; ++k) dst[m][k] = *(const LAS bf16x8*)(lds + PG8_SA(b, h) + aoff + m * 2048 + k * 1024); } while (0)
#define PG8_LDB(dst, b, h) do { _Pragma("unroll") for (int n = 0; n < 2; ++n) _Pragma("unroll") for (int k = 0; k < 2; ++k) dst[n][k] = *(const LAS bf16x8*)(lds + PG8_SB(b, h) + boff + n * 2048 + k * 1024); } while (0)
#define PG8_MMA(ai, bj, At, Bt) do { __builtin_amdgcn_s_setprio(1); _Pragma("unroll") for (int m = 0; m < 4; ++m) _Pragma("unroll") for (int n = 0; n < 2; ++n) _Pragma("unroll") for (int k = 0; k < 2; ++k) \
        acc[ai][bj][m][n] = __builtin_amdgcn_mfma_f32_16x16x32_bf16(Bt[n][k], At[m][k], acc[ai][bj][m][n], 0, 0, 0); __builtin_amdgcn_s_setprio(0); } while (0)
#define PG8_WAIT_V(n) asm volatile("s_waitcnt vmcnt(" #n ")" ::: "memory")
#define PG8_WAIT_L(n) asm volatile("s_waitcnt lgkmcnt(" #n ")" ::: "memory")
#define PG8_BAR __builtin_amdgcn_s_barrier()
#define PG8_SCHED __builtin_amdgcn_sched_barrier(0)
    Unit cur, nxt; int ui = 0;
    if (!S.next(0, cur)) return;
    int nt = cur.nt ? cur.nt : g.nt;
    f32x4 acc[2][2][4][2];
#pragma unroll
    for (int a = 0; a < 2; ++a)
#pragma unroll
        for (int b = 0; b < 2; ++b)
#pragma unroll
            for (int m = 0; m < 4; ++m)
#pragma unroll
                for (int n = 0; n < 2; ++n) acc[a][b][m][n] = (f32x4){0.f, 0.f, 0.f, 0.f};
    bf16x8 At[4][2], B0[2][2], B1[2][2];
    const char* cA = cur.A; const char* cB = cur.B;
    PG8_STAGE(PG8_SB(0, 0), cB, voffB); PG8_STAGE(PG8_SA(0, 0), cA, voffA); PG8_STAGE(PG8_SB(0, 1), cB + hstep, voffB); PG8_STAGE(PG8_SA(0, 1), cA + hstep, voffA);
    if (wr == 1) PG8_BAR;
    PG8_WAIT_V(4); PG8_BAR;
    PG8_STAGE(PG8_SB(1, 0), cB + kstep, voffB); PG8_STAGE(PG8_SA(1, 0), cA + kstep, voffA); PG8_STAGE(PG8_SB(1, 1), cB + hstep + kstep, voffB);
    PG8_WAIT_V(6); PG8_BAR;
    for (;;) {
        const bool has_next = S.next(ui + 1, nxt);
        const char* nA = has_next ? nxt.A : cA; const char* nB = has_next ? nxt.B : cB;
        for (int t = 0; t < nt; t += 2) {
            const bool last = (t == nt - 2);
            const char* a1 = cA + (size_t)(t + 1) * kstep;
            const char* a2 = last ? nA : cA + (size_t)(t + 2) * kstep; const char* b2 = last ? nB : cB + (size_t)(t + 2) * kstep;
            const char* a3 = a2 + kstep; const char* b3 = b2 + kstep;
            PG8_LDB(B0, 0, 0); PG8_SCHED; PG8_LDA(At, 0, 0); PG8_STAGE(PG8_SA(1, 1), a1 + hstep, voffA);
            PG8_WAIT_L(8); PG8_BAR; PG8_WAIT_L(0); PG8_MMA(0, 0, At, B0); PG8_BAR; PG8_SCHED;
            PG8_LDB(B1, 0, 1); PG8_STAGE(PG8_SB(0, 0), b2, voffB);
            PG8_BAR; PG8_WAIT_L(0); PG8_MMA(0, 1, At, B1); PG8_BAR;
            PG8_LDA(At, 0, 1); PG8_STAGE(PG8_SA(0, 0), a2, voffA);
            PG8_BAR; PG8_WAIT_L(0); PG8_MMA(1, 0, At, B0); PG8_BAR; PG8_SCHED;
            PG8_STAGE(PG8_SB(0, 1), b2 + hstep, voffB);
            PG8_WAIT_V(6); PG8_BAR; PG8_MMA(1, 1, At, B1); PG8_BAR;
            PG8_LDB(B0, 1, 0); PG8_SCHED; PG8_LDA(At, 1, 0); PG8_STAGE(PG8_SA(0, 1), a2 + hstep, voffA);
            PG8_WAIT_L(8); PG8_BAR; PG8_WAIT_L(0); PG8_MMA(0, 0, At, B0); PG8_BAR; PG8_SCHED;
            PG8_LDB(B1, 1, 1); PG8_STAGE(PG8_SB(1, 0), b3, voffB);
            PG8_BAR; PG8_WAIT_L(0); PG8_MMA(0, 1, At, B1); PG8_BAR;
            PG8_LDA(At, 1, 1); PG8_STAGE(PG8_SA(1, 0), a3, voffA);
            PG8_BAR; PG8_WAIT_L(0); PG8_MMA(1, 0, At, B0); PG8_BAR; PG8_SCHED;
            PG8_STAGE(PG8_SB(1, 1), b3 + hstep, voffB);
            PG8_WAIT_V(6); PG8_BAR; PG8_MMA(1, 1, At, B1); PG8_BAR;
        }
        E(acc, cur, wr, wc, fr, fq);
        if (!has_next) break;
#pragma unroll
        for (int a = 0; a < 2; ++a)
#pragma unroll
            for (int b = 0; b < 2; ++b)
#pragma unroll
                for (int m = 0; m < 4; ++m)
#pragma unroll
                    for (int n = 0; n < 2; ++n) acc[a][b][m][n] = (f32x4){0.f, 0.f, 0.f, 0.f};
        cur = nxt; cA = nA; cB = nB; ++ui; nt = cur.nt ? cur.nt : g.nt;
    }
    PG8_WAIT_V(0);
    if (wr == 0) PG8_BAR;
    PG8_BAR;
#undef PG8_SA
#undef PG8_SB
#undef PG8_STAGE
#undef PG8_LDA
#undef PG8_LDB
#undef PG8_MMA
#undef PG8_WAIT_V
#undef PG8_WAIT_L
#undef PG8_BAR
#undef PG8_SCHED
}
}

struct Epi1 {
    static constexpr bool PERM = true;
    P p;
    __device__ __forceinline__ void operator()(const f32x4 (&acc)[2][2][4][2], const pg8::Unit& u, int wr, int wc, int fr, int fq) const {
        unsigned char* ws = p.ws;
        const float* rstd = (const float*)(ws + O_RSTD1);
        const int row0 = u.pm * 256 + wr * 64 + fr, pn = u.pn;
        bf16_t* dst; int ld, cb; float sc = 1.f; float* fo = nullptr;
        if (pn < 2) { dst = (bf16_t*)(ws + O_GQ); ld = 512; cb = pn * 256; sc = 0.08838834764831845f; }
        else if (pn < 4) { dst = (bf16_t*)(ws + O_GK); ld = 512; cb = (pn - 2) * 256; }
        else if (pn < 8) { dst = (bf16_t*)(ws + O_GV); ld = 1024; cb = (pn - 4) * 256; }
        else if (pn < 12) { dst = (bf16_t*)(ws + O_GG); ld = 1024; cb = (pn - 8) * 256; }
        else if (pn < 16) { dst = (bf16_t*)(ws + O_AQ); ld = 1024; cb = (pn - 12) * 256; sc = 0.08838834764831845f * LOG2E; }
        else if (pn < 20) { dst = (bf16_t*)(ws + O_AK); ld = 1024; cb = (pn - 16) * 256; fo = p.out + OUT_KW; }
        else { dst = (bf16_t*)(ws + O_AV); ld = 1024; cb = (pn - 20) * 256; fo = p.out + OUT_VW; }
        float rsv[2][4];
#pragma unroll
        for (int ai = 0; ai < 2; ++ai)
#pragma unroll
            for (int m = 0; m < 4; ++m) rsv[ai][m] = rstd[row0 + ai * 128 + m * 16];
        asm volatile("" ::: "memory");
#pragma unroll
        for (int ai = 0; ai < 2; ++ai)
#pragma unroll
            for (int m = 0; m < 4; ++m) {
                const int row = row0 + ai * 128 + m * 16; const float rs = rsv[ai][m] * sc;
                const int t = row & 4095;
#pragma unroll
                for (int bj = 0; bj < 2; ++bj) {
                    const int c = cb + bj * 128 + wc * 32 + 8 * fq;
                    const f32x4 v0 = acc[ai][bj][m][0] * rs, v1 = acc[ai][bj][m][1] * rs;
                    u32x4 w; w.x = cvt_pk_bf16(v0[0], v0[1]); w.y = cvt_pk_bf16(v0[2], v0[3]); w.z = cvt_pk_bf16(v1[0], v1[1]); w.w = cvt_pk_bf16(v1[2], v1[3]);
                    *(u32x4*)(dst + (size_t)row * ld + c) = w;
                    if (fo && t >= 2048) { float* o = fo + ((size_t)((row >> 12) * 2048 + t - 2048)) * 1024 + c; __builtin_nontemporal_store(v0, (f32x4*)o); __builtin_nontemporal_store(v1, (f32x4*)(o + 4)); }
                }
            }
    }
};

struct EpiO {
    static constexpr bool PERM = true;
    P p;
    __device__ __forceinline__ void operator()(const f32x4 (&acc)[2][2][4][2], const pg8::Unit& u, int wr, int wc, int fr, int fq) const {
        unsigned char* ws = p.ws;
        const bf16_t* XB = (const bf16_t*)(ws + O_XB); bf16_t* X1B = (bf16_t*)(ws + O_X1B); float* ss2 = (float*)(ws + O_SUMS);
        const int row0 = u.pm * 256 + wr * 64 + fr, col0 = u.pn * 256 + wc * 32 + 8 * fq;
        u32x4 xin[2][4][2];
#pragma unroll
        for (int ai = 0; ai < 2; ++ai)
#pragma unroll
            for (int m = 0; m < 4; ++m)
#pragma unroll
                for (int bj = 0; bj < 2; ++bj) xin[ai][m][bj] = __builtin_nontemporal_load((const u32x4*)(XB + (size_t)(row0 + ai * 128 + m * 16) * DM + col0 + bj * 128));
        asm volatile("" ::: "memory");
#pragma unroll
        for (int ai = 0; ai < 2; ++ai)
#pragma unroll
            for (int m = 0; m < 4; ++m) {
                const int row = row0 + ai * 128 + m * 16; float s = 0.f;
#pragma unroll
                for (int bj = 0; bj < 2; ++bj) {
                    const size_t off = (size_t)row * DM + col0 + bj * 128;
                    const u32x4 xr = xin[ai][m][bj];
                    f32x4 v0 = acc[ai][bj][m][0], v1 = acc[ai][bj][m][1];
                    v0[0] += bflo(xr.x); v0[1] += bfhi(xr.x); v0[2] += bflo(xr.y); v0[3] += bfhi(xr.y);
                    v1[0] += bflo(xr.z); v1[1] += bfhi(xr.z); v1[2] += bflo(xr.w); v1[3] += bfhi(xr.w);
                    u32x4 w; w.x = cvt_pk_bf16(v0[0], v0[1]); w.y = cvt_pk_bf16(v0[2], v0[3]); w.z = cvt_pk_bf16(v1[0], v1[1]); w.w = cvt_pk_bf16(v1[2], v1[3]);
                    *(u32x4*)(X1B + off) = w;
                    s += (v0[0] * v0[0] + v0[1] * v0[1]) + (v0[2] * v0[2] + v0[3] * v0[3]) + (v1[0] * v1[0] + v1[1] * v1[1]) + (v1[2] * v1[2] + v1[3] * v1[3]);
                }
                s += __shfl_xor(s, 16); s += __shfl_xor(s, 32);
                if (fq == 0) __hip_atomic_fetch_add(ss2 + row, s, __ATOMIC_RELAXED, __HIP_MEMORY_SCOPE_AGENT);
            }
    }
};

struct EpiU {
    static constexpr bool PERM = true;
    P p;
    __device__ __forceinline__ void operator()(const f32x4 (&acc)[2][2][4][2], const pg8::Unit& u, int wr, int wc, int fr, int fq) const {
        unsigned char* ws = p.ws;
        const float* ss2 = (const float*)(ws + O_SUMS); bf16_t* HM = (bf16_t*)(ws + O_HM);
        const int row0 = u.pm * 256 + wr * 64 + fr, col0 = u.pn * 256 + wc * 32 + 8 * fq;
        float rsv[2][4];
#pragma unroll
        for (int ai = 0; ai < 2; ++ai)
#pragma unroll
            for (int m = 0; m < 4; ++m) rsv[ai][m] = ss2[row0 + ai * 128 + m * 16];
        asm volatile("" ::: "memory");
#pragma unroll
        for (int ai = 0; ai < 2; ++ai)
#pragma unroll
            for (int m = 0; m < 4; ++m) {
                const int row = row0 + ai * 128 + m * 16; const float rs = rsqrtf(rsv[ai][m] * (1.f / DM) + EPS);
#pragma unroll
                for (int bj = 0; bj < 2; ++bj) {
                    f32x4 v0 = acc[ai][bj][m][0] * rs, v1 = acc[ai][bj][m][1] * rs;
#pragma unroll
                    for (int j = 0; j < 4; ++j) { v0[j] = fmaxf(v0[j], 0.f); v0[j] *= v0[j]; v1[j] = fmaxf(v1[j], 0.f); v1[j] *= v1[j]; }
                    u32x4 w; w.x = cvt_pk_bf16(v0[0], v0[1]); w.y = cvt_pk_bf16(v0[2], v0[3]); w.z = cvt_pk_bf16(v1[0], v1[1]); w.w = cvt_pk_bf16(v1[2], v1[3]);
                    *(u32x4*)(HM + (size_t)row * DFF + col0 + bj * 128) = w;
                }
            }
    }
};

struct EpiD {
    static constexpr bool PERM = true;
    P p;
    __device__ __forceinline__ void operator()(const f32x4 (&acc)[2][2][4][2], const pg8::Unit& u, int wr, int wc, int fr, int fq) const {
        const bf16_t* X1B = (const bf16_t*)(p.ws + O_X1B); bf16_t* X2B = (bf16_t*)(p.ws + O_CAT);
        const int row0 = u.pm * 256 + wr * 64 + fr, col0 = u.pn * 256 + wc * 32 + 8 * fq;
        u32x4 xin[2][4][2];
#pragma unroll
        for (int ai = 0; ai < 2; ++ai)
#pragma unroll
            for (int m = 0; m < 4; ++m)
#pragma unroll
                for (int bj = 0; bj < 2; ++bj) xin[ai][m][bj] = __builtin_nontemporal_load((const u32x4*)(X1B + (size_t)(row0 + ai * 128 + m * 16) * DM + col0 + bj * 128));
        asm volatile("" ::: "memory");
#pragma unroll
        for (int ai = 0; ai < 2; ++ai)
#pragma unroll
            for (int m = 0; m < 4; ++m) {
                const int row = row0 + ai * 128 + m * 16;
#pragma unroll
                for (int bj = 0; bj < 2; ++bj) {
                    const size_t off = (size_t)row * DM + col0 + bj * 128;
                    const u32x4 xr = xin[ai][m][bj];
                    f32x4 v0 = acc[ai][bj][m][0], v1 = acc[ai][bj][m][1];
                    v0[0] += bflo(xr.x); v0[1] += bfhi(xr.x); v0[2] += bflo(xr.y); v0[3] += bfhi(xr.y);
                    v1[0] += bflo(xr.z); v1[1] += bfhi(xr.z); v1[2] += bflo(xr.w); v1[3] += bfhi(xr.w);
                    u32x4 w; w.x = cvt_pk_bf16(v0[0], v0[1]); w.y = cvt_pk_bf16(v0[2], v0[3]); w.z = cvt_pk_bf16(v1[0], v1[1]); w.w = cvt_pk_bf16(v1[2], v1[3]);
                    *(u32x4*)(X2B + off) = w;
                }
            }
    }
};

struct EpiPart {
    static constexpr bool PERM = false;
    float* C; int ldc;
    __device__ __forceinline__ void operator()(const f32x4 (&acc)[2][2][4][2], const pg8::Unit& u, int wr, int wc, int fr, int fq) const {
        const int row0 = wr * 64 + fr, col0 = u.pn * 256 + wc * 32 + 4 * fq;
        float* base = C + (size_t)u.pm * TS * ldc;
#pragma unroll
        for (int m = 0; m < 4; ++m) {
            float* rp = base + (size_t)(row0 + m * 16) * ldc + col0;
#pragma unroll
            for (int bj = 0; bj < 2; ++bj)
#pragma unroll
                for (int n = 0; n < 2; ++n) *(f32x4*)(rp + bj * 128 + n * 16) = acc[0][bj][m][n];
        }
    }
};

struct EpiPartP {
    float* C; int ldc;
    __device__ __forceinline__ void operator()(const f32x4 (&acc)[2][2][4][2], const pg8::Unit& u, int wr, int wc, int fr, int fq) const {
        const int row0 = wr * 64 + fr, col0 = u.pn * 256 + wc * 32 + 8 * fq;
        float* base = C + (size_t)u.pm * TS * ldc;
#pragma unroll
        for (int m = 0; m < 4; ++m) {
            float* rp = base + (size_t)(row0 + m * 16) * ldc + col0;
#pragma unroll
            for (int bj = 0; bj < 2; ++bj) { *(f32x4*)(rp + bj * 128) = acc[0][bj][m][0]; *(f32x4*)(rp + bj * 128 + 4) = acc[0][bj][m][1]; }
        }
    }
};
template <class Main> struct EpiBoth {
    static constexpr bool PERM = true, AFTER_DRAIN = false;
    Main m; EpiPartP q;
    __device__ __forceinline__ void operator()(const f32x4 (&acc)[2][2][4][2], const pg8::Unit& u, int wr, int wc, int fr, int fq) const {
        if (u.kind == 0) m(acc, u, wr, wc, fr, fq); else q(acc, u, wr, wc, fr, fq);
    }
};

template <int NB>
__device__ __forceinline__ void skinny(const bf16_t* A, int lda, const bf16_t* Bt, int ldb, int klen, f32x4 (&acc)[NB], int lane) {
    const int fr = lane & 15, fq = lane >> 4;
    const bf16x8* ap = (const bf16x8*)(A + (size_t)fr * lda + fq * 8);
    const bf16x8* bp[NB];
#pragma unroll
    for (int nb = 0; nb < NB; ++nb) { bp[nb] = (const bf16x8*)(Bt + (size_t)(nb * 16 + fr) * ldb + fq * 8); acc[nb] = (f32x4){0.f, 0.f, 0.f, 0.f}; }
    const int nks = klen / 32;
#pragma unroll 8
    for (int ks = 0; ks < nks; ++ks) {
        const bf16x8 a = ap[ks * 4];
#pragma unroll
        for (int nb = 0; nb < NB; ++nb) { const bf16x8 b = bp[nb][ks * 4]; acc[nb] = mfma16(b, a, acc[nb]); }
    }
}

__device__ __forceinline__ void tr_item(const float* W, int ldw, int k0, int n0, int nvalid, const float* nw, bf16_t* WT, int K, int drow0, LAS float* scr, int lane) {
    float tv[64];
    { const float* wp = W + (size_t)k0 * ldw + n0 + (lane < nvalid ? lane : 0);
#pragma unroll
      for (int i = 0; i < 64; ++i) tv[i] = __builtin_nontemporal_load(wp + (size_t)i * ldw);
#pragma unroll
      for (int i = 0; i < 64; ++i) { float v = tv[i]; if (nw) v *= nw[k0 + i]; scr[i * 65 + lane] = v; } }
    asm volatile("s_waitcnt lgkmcnt(0)" ::: "memory");
    const int c = lane & 7;
#pragma unroll
    for (int j = 0; j < 8; ++j) { const int n = (lane >> 3) + 8 * j; const LAS float* s = scr + (8 * c) * 65 + n;
        u32x4 o; o.x = cvt_pk_bf16(s[0 * 65], s[1 * 65]); o.y = cvt_pk_bf16(s[2 * 65], s[3 * 65]); o.z = cvt_pk_bf16(s[4 * 65], s[5 * 65]); o.w = cvt_pk_bf16(s[6 * 65], s[7 * 65]);
        if (n < nvalid) *(u32x4*)(WT + (size_t)(drow0 + n) * K + k0 + 8 * c) = o; }
    asm volatile("s_waitcnt lgkmcnt(0)" ::: "memory");
}

__device__ __forceinline__ void phase0(const P& p, LAS unsigned char* lds, int tid, int G) {
    unsigned char* ws = p.ws;
    const int wave = tid >> 6, lane = tid & 63;
    const int gw = blockIdx.x * 8 + wave, NGW = G * 8;
    float* sums = (float*)(ws + O_SUMS);
    for (int i = blockIdx.x * NTHR + tid; i < MT; i += G * NTHR) sums[i] = 0.f;
    float* rstd1 = (float*)(ws + O_RSTD1); bf16_t* XB = (bf16_t*)(ws + O_XB);
    for (int mb = gw; mb < MT; mb += 2 * NGW) {
        f32x4 v[2][8];
#pragma unroll
        for (int q = 0; q < 2; ++q) { const int m = mb + q * NGW;
            if (m < MT) { const float* xr = m < TP ? p.x_prompt + (size_t)m * DM : p.x_sample + (size_t)(m - TP) * DM;
#pragma unroll
                for (int j = 0; j < 8; ++j) v[q][j] = __builtin_nontemporal_load((const f32x4*)xr + lane + 64 * j); } }
        asm volatile("" ::: "memory");
#pragma unroll
        for (int q = 0; q < 2; ++q) { const int m = mb + q * NGW;
            if (m < MT) { float s = 0.f;
#pragma unroll
                for (int j = 0; j < 8; ++j) s += (v[q][j][0] * v[q][j][0] + v[q][j][1] * v[q][j][1]) + (v[q][j][2] * v[q][j][2] + v[q][j][3] * v[q][j][3]);
                s = wave_sum(s);
                if (lane == 0) rstd1[m] = rsqrtf(s * (1.f / DM) + EPS);
                u32x2* o = (u32x2*)(XB + (size_t)m * DM);
#pragma unroll
                for (int j = 0; j < 8; ++j) { u32x2 w; w.x = cvt_pk_bf16(v[q][j][0], v[q][j][1]); w.y = cvt_pk_bf16(v[q][j][2], v[q][j][3]); o[lane + 64 * j] = w; } } }
    }
    LAS float* scr = (LAS float*)(lds + wave * 16640);
    bf16_t* BT1 = (bf16_t*)(ws + O_BT1); bf16_t* BTG = (bf16_t*)(ws + O_BTG);
    constexpr int I_IN = 32 * 96, I_G = 32;
    constexpr int NIT = I_IN + I_G;
    for (int it = gw; it < NIT; it += NGW) {
        int r = it;
        if (r < I_IN) { const int kb = r / 96, nb = r % 96; const int src_n0 = nb < 48 ? nb * 64 : 3088 + (nb - 48) * 64;
            tr_item(p.w_in, 6160, kb * 64, src_n0, 64, p.attn_norm_w, BT1, DM, nb * 64, scr, lane); continue; }
        r -= I_IN;
        tr_item(p.w_in, 6160, r * 64, 3072, 16, p.attn_norm_w, BTG, DM, 0, scr, lane);
    }
}
__device__ __forceinline__ void side_transposes(const P& p, LAS unsigned char* lds, int sw, int lane, int G) {
    unsigned char* ws = p.ws;
    LAS float* scr = (LAS float*)(lds + sw * 16640);
    bf16_t* BTO = (bf16_t*)(ws + O_BTO); bf16_t* BTU = (bf16_t*)(ws + O_BTU); bf16_t* BTD = (bf16_t*)(ws + O_BTD);
    constexpr int I_O = 32 * 32, I_U = 32 * 128, I_D = 128 * 32;
    for (int it = sw * G + blockIdx.x; it < I_O + I_U + I_D; it += 4 * G) {
        int r = it;
        if (r < I_O) { const int kb = r / 32, nb = r % 32; tr_item(p.w_out, DM, kb * 64, nb * 64, 64, nullptr, BTO, DM, nb * 64, scr, lane); continue; }
        r -= I_O;
        if (r < I_U) { const int kb = r / 128, nb = r % 128; tr_item(p.w_up, DFF, kb * 64, nb * 64, 64, p.ffn_norm_w, BTU, DM, nb * 64, scr, lane); continue; }
        r -= I_U;
        { const int kb = r / 32, nb = r % 32; tr_item(p.w_down, DM, kb * 64, nb * 64, 64, nullptr, BTD, DFF, nb * 64, scr, lane); }
    }
}

__device__ __forceinline__ void phase1_skinny(const P& p, LAS unsigned char* lds, int tid, int G) {
    unsigned char* ws = p.ws;
    const int wave = tid >> 6, lane = tid & 63, fr = lane & 15, fq = lane >> 4;
    const bf16_t* XB = (const bf16_t*)(ws + O_XB); const float* rstd1 = (const float*)(ws + O_RSTD1);
    float* GLR = (float*)(ws + O_GLR);
    const int rg = wave >> 2, kq = wave & 3;
    for (int k = 0; k * G < MT / 32; ++k) {
        const int it = k * G + ((k & 1) ? (G - 1 - (int)blockIdx.x) : (int)blockIdx.x);
        if (it >= MT / 32) break;
        f32x4 acc[1];
        skinny<1>(XB + (size_t)(it * 32 + rg * 16) * DM + kq * 512, DM, (const bf16_t*)(ws + O_BTG) + kq * 512, DM, 512, acc, lane);
        __syncthreads();
        *(LAS f32x4*)(lds + (wave * 64 + lane) * 16) = acc[0];
        __syncthreads();
        if (kq == 0) {
            f32x4 v = acc[0];
#pragma unroll
            for (int q = 1; q < 4; ++q) v += *(const LAS f32x4*)(lds + ((wave + q) * 64 + lane) * 16);
            const int row = it * 32 + rg * 16 + fr;
            *(f32x4*)(GLR + (size_t)row * 16 + 4 * fq) = v * rstd1[row];
        }
    }
}

__device__ __forceinline__ void attn_issue(const P& p, int it, int tid, u32x4 (&kv)[8], u32x4 (&vv)[8], bf16x8 (&qf)[4]) {
    unsigned char* ws = p.ws;
    const int wid = tid >> 6, lane = tid & 63, fr = lane & 15, fq = lane >> 4;
    const int g = it >> 9, rem = it & 511, b = rem >> 8, h = (rem >> 5) & 7, sub = rem & 31;
    const int dsh = 2 * g, d = 1 << dsh, nbs = 5 - dsh;
    const int r = sub >> nbs, n = sub & ((1 << nbs) - 1);
    const bf16_t* AKp = (const bf16_t*)(ws + O_AK) + (size_t)b * SEQ * 1024 + h * 128;
    const bf16_t* AVp = (const bf16_t*)(ws + O_AV) + (size_t)b * SEQ * 1024 + h * 128;
#pragma unroll
    for (int ps = 0; ps < 8; ++ps) {
        const int row = (tid >> 4) + 32 * ps, ch = tid & 15, lk = 128 * (n - 1) + row;
        kv[ps] = (u32x4){0u, 0u, 0u, 0u}; vv[ps] = (u32x4){0u, 0u, 0u, 0u};
        if (lk >= 0) { const size_t t = (size_t)lk * d + r; kv[ps] = *(const u32x4*)(AKp + t * 1024 + ch * 8); vv[ps] = *(const u32x4*)(AVp + t * 1024 + ch * 8); }
    }
    const int tq = (128 * n + 16 * wid + fr) * d + r;
    const bf16_t* qp = (const bf16_t*)(ws + O_AQ) + ((size_t)b * SEQ + tq) * 1024 + h * 128 + fq * 8;
#pragma unroll
    for (int ks = 0; ks < 4; ++ks) qf[ks] = *(const bf16x8*)(qp + 32 * ks);
}

__device__ __forceinline__ void attn_prompt_loop(const P& p, LAS unsigned char* lds, int tid, int G) {
    unsigned char* ws = p.ws;
    const int wid = tid >> 6, lane = tid & 63, fr = lane & 15, fq = lane >> 4;
    u32x4 kvr[8], vvr[8]; bf16x8 qn[4];
    int it = blockIdx.x;
    if (it < 1536) attn_issue(p, it, tid, kvr, vvr, qn);
    for (; it < 1536; it += G) {
    const int g = it >> 9, rem = it & 511, b = rem >> 8, h = (rem >> 5) & 7, sub = rem & 31;
    const int dsh = 2 * g, d = 1 << dsh, nbs = 5 - dsh;
    const int r = sub >> nbs, n = sub & ((1 << nbs) - 1);
    __syncthreads();
#pragma unroll
    for (int ps = 0; ps < 8; ++ps) {
        const int row = (tid >> 4) + 32 * ps, ch = tid & 15;
        *(LAS u32x4*)(lds + offb(row, ch)) = kvr[ps]; *(LAS u32x4*)(lds + 65536 + offb(row, ch)) = vvr[ps];
    }
    const int tq = (128 * n + 16 * wid + fr) * d + r;
    __syncthreads();
    const int kb0 = 2 * (wid >> 1);
    f32x4 sacc[10];
#pragma unroll
    for (int kbi = 0; kbi < 10; ++kbi) {
        sacc[kbi] = (f32x4){0.f, 0.f, 0.f, 0.f};
        const unsigned key = 16 * (kb0 + kbi) + fr;
#pragma unroll
        for (int ks = 0; ks < 4; ++ks) { const bf16x8 kf = *(const LAS bf16x8*)(lds + offb(key, 4 * ks + fq)); sacc[kbi] = mfma16(kf, qn[ks], sacc[kbi]); }
    }
    int rel = 16 * (wid & 1) + fr - 4 * fq; asm volatile("" : "+v"(rel));
    const float slope2 = fexp2(-(float)(h + 1)) * LOG2E * (float)d;
    const float c0 = -slope2 * (float)(rel + 128);
    float mx = -INFINITY;
#pragma unroll
    for (int kbi = 0; kbi < 10; ++kbi) {
        const bool blk_ok = (n > 0) || (kb0 + kbi >= 8);
#pragma unroll
        for (int j = 0; j < 4; ++j) {
            bool valid = blk_ok;
            if (kbi <= 1) valid = valid && (rel - 16 * kbi - j <= 0);
            if (kbi >= 8) valid = valid && (rel + 128 - 16 * kbi - j >= 0);
            const float s = valid ? sacc[kbi][j] + (c0 + slope2 * (float)(16 * kbi + j)) : -INFINITY;
            sacc[kbi][j] = s; mx = fmaxf(mx, s);
        }
    }
    mx = fmaxf(mx, __shfl_xor(mx, 16)); mx = fmaxf(mx, __shfl_xor(mx, 32));
    float l = 0.f;
#pragma unroll
    for (int kbi = 0; kbi < 10; ++kbi)
#pragma unroll
        for (int j = 0; j < 4; ++j) { const float pe = fexp2(sacc[kbi][j] - mx); sacc[kbi][j] = pe; l += pe; }
    l += __shfl_xor(l, 16); l += __shfl_xor(l, 32);
    if (it + G < 1536) attn_issue(p, it + G, tid, kvr, vvr, qn);
    f32x4 oacc[8];
#pragma unroll
    for (int eb = 0; eb < 8; ++eb) oacc[eb] = (f32x4){0.f, 0.f, 0.f, 0.f};
    const unsigned vbase = (unsigned)(size_t)(lds + 65536);
    const unsigned q_ = (lane & 15) >> 2, pp = lane & 3;
    const unsigned a00 = vbase + offb(16 * kb0 + 4 * fq + q_, (pp >> 1)) + 8 * (pp & 1);
#pragma unroll
    for (int ks = 0; ks < 5; ++ks) {
        const bf16x8 pf = pack8(sacc[2 * ks], sacc[2 * ks + 1]);
#pragma unroll
        for (int e4 = 0; e4 < 2; ++e4) {
            unsigned av[4]; bf16x8 vf[4];
#pragma unroll
            for (int eb = 0; eb < 4; ++eb) av[eb] = (a00 + (unsigned)(ks * 8192)) ^ (unsigned)((e4 * 4 + eb) << 5);
            tr_read_4x2(av, vf);
#pragma unroll
            for (int eb = 0; eb < 4; ++eb) oacc[e4 * 4 + eb] = mfma16(vf[eb], pf, oacc[e4 * 4 + eb]);
        }
    }
    const float inv = 1.f / l;
    bf16_t* op = (bf16_t*)(ws + O_OATT) + ((size_t)g * TP + (size_t)b * SEQ + tq) * 1024 + h * 128 + 4 * fq;
#pragma unroll
    for (int eb = 0; eb < 8; ++eb) { const f32x4 o = oacc[eb] * inv; u32x2 w; w.x = cvt_pk_bf16(o[0], o[1]); w.y = cvt_pk_bf16(o[2], o[3]); *(u32x2*)(op + 16 * eb) = w; }
    if (fq == 0) ((float*)(ws + O_LSE))[((size_t)g * TP + (size_t)b * SEQ + tq) * 8 + h] = mx + flog2(l);
    }
}

__device__ __forceinline__ void attn_sample_item(const P& p, int wi, int lane) {
    unsigned char* ws = p.ws;
    const int bs = wi >> 5, i = (wi >> 3) & 3, h = wi & 7;
    const int kg = lane >> 4, li = lane & 15;
    const int srow = bs * 4 + i;
    const float* ACC1 = (const float*)(ws + O_ACC1); const float* rstd1 = (const float*)(ws + O_RSTD1);
    float q[8];
    { const float rq = rstd1[TP + srow] * (0.08838834764831845f * LOG2E);
      const f32x4 q0 = acc1_4(ACC1, srow, 3072 + h * 128 + 8 * li), q1 = acc1_4(ACC1, srow, 3072 + h * 128 + 8 * li + 4);
      q[0] = q0[0] * rq; q[1] = q0[1] * rq; q[2] = q0[2] * rq; q[3] = q0[3] * rq; q[4] = q1[0] * rq; q[5] = q1[1] * rq; q[6] = q1[2] * rq; q[7] = q1[3] * rq; }
    if (kg == 0) {
        const float rs = rstd1[TP + srow];
        float* ko = p.out + OUT_KN + (size_t)srow * 1024 + h * 128 + 8 * li; float* vo = p.out + OUT_VN + (size_t)srow * 1024 + h * 128 + 8 * li;
        *(f32x4*)ko = acc1_4(ACC1, srow, 4096 + h * 128 + 8 * li) * rs; *(f32x4*)(ko + 4) = acc1_4(ACC1, srow, 4096 + h * 128 + 8 * li + 4) * rs;
        *(f32x4*)vo = acc1_4(ACC1, srow, 5120 + h * 128 + 8 * li) * rs; *(f32x4*)(vo + 4) = acc1_4(ACC1, srow, 5120 + h * 128 + 8 * li + 4) * rs;
    }
    float m = -1e30f, l = 0.f, acc[8];
#pragma unroll
    for (int e = 0; e < 8; ++e) acc[e] = 0.f;
    const float sl = fexp2(-(float)(h + 1)) * LOG2E;
    for (int g = 0; g < 3; ++g) {
        const int d = 1 << (2 * g);
#pragma unroll 3
        for (int jj = 0; jj < 33; ++jj) {
            const int j = 4 * jj + kg; const bool valid = j <= 128; const int jc = valid ? j : 128;
            const int idx = 2048 + i - d * jc;
            f32x4 k0, k1, v0, v1;
            if (idx < 2048) { const size_t off = (((size_t)bs * 2048 + idx) * 8 + h) * 128 + 8 * li;
                k0 = __builtin_nontemporal_load((const f32x4*)(p.cache_k + off)); k1 = __builtin_nontemporal_load((const f32x4*)(p.cache_k + off + 4)); v0 = __builtin_nontemporal_load((const f32x4*)(p.cache_v + off)); v1 = __builtin_nontemporal_load((const f32x4*)(p.cache_v + off + 4)); }
            else { const int nr = bs * 4 + (idx - 2048); const float rsn = rstd1[TP + nr]; const int c0 = 4096 + h * 128 + 8 * li;
                k0 = acc1_4(ACC1, nr, c0) * rsn; k1 = acc1_4(ACC1, nr, c0 + 4) * rsn; v0 = acc1_4(ACC1, nr, c0 + 1024) * rsn; v1 = acc1_4(ACC1, nr, c0 + 1028) * rsn; }
            float dot = (q[0] * k0[0] + q[1] * k0[1]) + (q[2] * k0[2] + q[3] * k0[3]) + (q[4] * k1[0] + q[5] * k1[1]) + (q[6] * k1[2] + q[7] * k1[3]);
            dot += __shfl_xor(dot, 1); dot += __shfl_xor(dot, 2); dot += __shfl_xor(dot, 4); dot += __shfl_xor(dot, 8);
            const float s = valid ? dot - sl * (float)(d * j) : -INFINITY;
            const float mn = fmaxf(m, s), sc = fexp2(m - mn), pe = fexp2(s - mn);
            l = l * sc + pe;
            acc[0] = acc[0] * sc + pe * v0[0]; acc[1] = acc[1] * sc + pe * v0[1]; acc[2] = acc[2] * sc + pe * v0[2]; acc[3] = acc[3] * sc + pe * v0[3];
            acc[4] = acc[4] * sc + pe * v1[0]; acc[5] = acc[5] * sc + pe * v1[1]; acc[6] = acc[6] * sc + pe * v1[2]; acc[7] = acc[7] * sc + pe * v1[3];
            m = mn;
        }
    }
    float mt = fmaxf(m, __shfl_xor(m, 16)); mt = fmaxf(mt, __shfl_xor(mt, 32));
    const float f = fexp2(m - mt);
    l *= f; l += __shfl_xor(l, 16); l += __shfl_xor(l, 32);
    const float inv = 1.f / l;
    float* o = (float*)(ws + O_ATTS) + (size_t)srow * 1024 + h * 128 + 8 * li;
#pragma unroll
    for (int e = 0; e < 8; ++e) { float a = acc[e] * f; a += __shfl_xor(a, 16); a += __shfl_xor(a, 32); acc[e] = a * inv; }
    if (kg == 0) { *(f32x4*)o = (f32x4){acc[0], acc[1], acc[2], acc[3]}; *(f32x4*)(o + 4) = (f32x4){acc[4], acc[5], acc[6], acc[7]}; }
}

__device__ __forceinline__ float logsig(float x) { return fminf(x, 0.f) - __logf(1.f + __expf(-fabsf(x))); }

__device__ __forceinline__ void gla_a_item(const P& p, LAS unsigned char* lds, int it, int tid) {
    unsigned char* ws = p.ws;
    const int wid = tid >> 6, lane = tid & 63, fr = lane & 15, fq = lane >> 4;
    const int bh = it >> 6, c = it & 63, b = bh >> 2, h = bh & 3;
    const int row0 = b * SEQ + 64 * c;
    LAS float* sGLR = (LAS float*)lds;
    LAS float* sTot = (LAS float*)(lds + 4096);
    LAS unsigned char* sKt = lds + 8192;
    LAS unsigned char* sV = lds + 8192 + 16384;
    __syncthreads();
    if (tid < 256) *(LAS f32x4*)(sGLR + 4 * tid) = *(const f32x4*)((const float*)(ws + O_GLR) + (size_t)row0 * 16 + 4 * tid);
    const bf16_t* GV = (const bf16_t*)(ws + O_GV);
#pragma unroll
    for (int i = 0; i < 4; ++i) { const int q = tid + 512 * i, row = q >> 5, ch32 = q & 31;
        const u32x4 v = *(const u32x4*)(GV + (size_t)(row0 + row) * 1024 + h * 256 + ch32 * 8);
        *(LAS u32x4*)(sV + (ch32 >> 4) * 16384 + offb(row, ch32 & 15)) = v; }
    const int k = tid & 127, tg = tid >> 7;
    float w[16];
#pragma unroll
    for (int r = 0; r < 16; ++r) w[r] = p.w_gk_up[r * 512 + h * 128 + k];
    const float bias = p.b_gk[h * 128 + k];
    float kvals[16];
    { const bf16_t* GKp = (const bf16_t*)(ws + O_GK) + (size_t)(row0 + tg * 16) * 512 + h * 128 + k;
#pragma unroll
      for (int tt = 0; tt < 16; ++tt) kvals[tt] = bf2f(GKp[(size_t)tt * 512]); }
    __syncthreads();
    float cs[16]; float run = 0.f;
#pragma unroll
    for (int tt = 0; tt < 16; ++tt) { const int t = tg * 16 + tt; float x = bias;
#pragma unroll
        for (int r = 0; r < 16; ++r) x += sGLR[t * 16 + r] * w[r];
        run += logsig(x) * (1.f / 16.f); cs[tt] = run; }
    sTot[tg * 128 + k] = run;
    __syncthreads();
    float off = 0.f, tot = 0.f;
#pragma unroll
    for (int gi = 0; gi < 4; ++gi) { const float v = sTot[gi * 128 + k]; if (gi < tg) off += v; tot += v; }
    float* BCUM = (float*)(ws + O_BCUM);
#pragma unroll
    for (int tt = 0; tt < 16; ++tt) { const int t = tg * 16 + tt; const float bt = off + cs[tt];
        BCUM[(size_t)(row0 + t) * 512 + h * 128 + k] = bt;
        const float kval = kvals[tt];
        *(LAS bf16_t*)(sKt + offb(t, k >> 3) + 2 * (k & 7)) = f2bf(kval * __expf(tot - bt)); }
    if (tg == 0) ((float*)(ws + O_DEC))[(size_t)it * 128 + k] = __expf(tot);
    __syncthreads();
    const unsigned q_ = (lane & 15) >> 2, pp = lane & 3;
    const unsigned kbase = (unsigned)(size_t)sKt, vb0 = (unsigned)(size_t)sV;
    bf16x8 kf[2];
#pragma unroll
    for (int ks = 0; ks < 2; ++ks) { const unsigned R0 = 32 * ks + 8 * fq + q_;
        kf[ks] = tr_read2(kbase + offb(R0, 2 * wid + (pp >> 1)) + 8 * (pp & 1), kbase + offb(R0 + 4, 2 * wid + (pp >> 1)) + 8 * (pp & 1)); }
    float* DS = (float*)(ws + O_DS) + ((size_t)it * 128 + 16 * wid + fr) * 256 + 4 * fq;
#pragma unroll 4
    for (int vb = 0; vb < 16; ++vb) {
        const unsigned vbase = vb0 + (vb >> 3) * 16384; const int cb = vb & 7;
        f32x4 a = (f32x4){0.f, 0.f, 0.f, 0.f};
        { const unsigned R0 = 8 * fq + q_; bf16x8 v0, v1;
          tr_read2x2(vbase + offb(R0, 2 * cb + (pp >> 1)) + 8 * (pp & 1), vbase + offb(R0 + 4, 2 * cb + (pp >> 1)) + 8 * (pp & 1),
                     vbase + offb(R0 + 32, 2 * cb + (pp >> 1)) + 8 * (pp & 1), vbase + offb(R0 + 36, 2 * cb + (pp >> 1)) + 8 * (pp & 1), v0, v1);
          a = mfma16(v0, kf[0], a); a = mfma16(v1, kf[1], a); }
        *(f32x4*)(DS + 16 * vb) = a;
    }
}

__device__ __forceinline__ void gla_sample_item(const P& p, LAS unsigned char* lds, int it, int tid) {
    unsigned char* ws = p.ws;
    const int bs = it >> 3, h = (it >> 1) & 3, vh = it & 1;
    LAS float* sA = (LAS float*)lds;
    LAS float* sK = sA + 512;
    LAS float* sQ = sK + 512;
    LAS float* sRed = sQ + 512;
    const float* ACC1 = (const float*)(ws + O_ACC1); const float* rstd1 = (const float*)(ws + O_RSTD1);
    __syncthreads();
    { const int i = tid >> 7, k = tid & 127; const int row = TP + bs * 4 + i;
      const float* glr = (const float*)(ws + O_GLR) + (size_t)row * 16;
      float x = p.b_gk[h * 128 + k];
#pragma unroll
      for (int r = 0; r < 16; ++r) x += glr[r] * p.w_gk_up[r * 512 + h * 128 + k];
      sA[tid] = __expf(logsig(x) * (1.f / 16.f));
      const float rs = rstd1[row];
      sK[tid] = acc1_1(ACC1, bs * 4 + i, 512 + h * 128 + k) * rs;
      sQ[tid] = acc1_1(ACC1, bs * 4 + i, h * 128 + k) * rs * 0.08838834764831845f; }
    const int kq = tid >> 5, vc4 = tid & 31, v = vh * 128 + 4 * vc4;
    const float* s0 = p.state_gla + (((size_t)bs * 4 + h) * 128 + kq * 8) * 256 + v;
    f32x4 S[8];
#pragma unroll
    for (int kk = 0; kk < 8; ++kk) S[kk] = __builtin_nontemporal_load((const f32x4*)(s0 + (size_t)kk * 256));
    f32x4 vv[4];
#pragma unroll
    for (int i = 0; i < 4; ++i) vv[i] = acc1_4(ACC1, bs * 4 + i, 1024 + h * 256 + v) * rstd1[TP + bs * 4 + i];
    __syncthreads();
    float* GLAOS = (float*)(ws + O_GLAOS);
    LAS float* sRed4 = sRed;
#pragma unroll
    for (int i = 0; i < 4; ++i) {
        f32x4 po = (f32x4){0.f, 0.f, 0.f, 0.f};
#pragma unroll
        for (int kk = 0; kk < 8; ++kk) { const int k = kq * 8 + kk; S[kk] = S[kk] * sA[i * 128 + k] + vv[i] * sK[i * 128 + k]; po += S[kk] * sQ[i * 128 + k]; }
        *(LAS f32x4*)(sRed4 + (i * 16 + kq) * 128 + 4 * vc4) = po;
    }
    __syncthreads();
    { const int i = tid >> 7, vcol = tid & 127; float o = 0.f;
#pragma unroll
      for (int g2 = 0; g2 < 16; ++g2) o += sRed4[(i * 16 + g2) * 128 + vcol];
      GLAOS[(size_t)(bs * 4 + i) * 1024 + h * 256 + vh * 128 + vcol] = o; }
    float* so = p.out + OUT_GS + (((size_t)bs * 4 + h) * 128 + kq * 8) * 256 + v;
#pragma unroll
    for (int kk = 0; kk < 8; ++kk) __builtin_nontemporal_store(S[kk], (f32x4*)(so + (size_t)kk * 256));
}

__device__ __forceinline__ void phase3(const P& p, int tid, int G) {
    unsigned char* ws = p.ws;
    const int wave = tid >> 6, lane = tid & 63;
    bf16_t* CAT = (bf16_t*)(ws + O_CAT);
    {
        const float* DS = (const float*)(ws + O_DS); const float* DEC = (const float*)(ws + O_DEC); bf16_t* SC = (bf16_t*)(ws + O_SC);
        const bf16_t* OATT = (const bf16_t*)(ws + O_OATT); const float* LSE = (const float*)(ws + O_LSE);
        const int nscan = 8 * 128 * 128, stride_t = G * NTHR, stride_w = G * 8;
        int e2 = blockIdx.x * NTHR + tid, row = blockIdx.x * 8 + wave;
        while (e2 < nscan || row < TP) {
            const bool do_scan = e2 < nscan;
            const int bh = e2 >> 14, k = (e2 >> 7) & 127, v = (e2 & 127) * 2;
            f32x2 S = (f32x2){0.f, 0.f};
            for (int seg = 0; seg < 4; ++seg) {
                const bool do_row = row < TP;
                const int h = lane >> 3;
                float l0 = 0.f, l1 = 0.f, l2 = 0.f; u32x4 r[3][2];
                if (do_row) {
                    l0 = LSE[((size_t)0 * TP + row) * 8 + h]; l1 = LSE[((size_t)1 * TP + row) * 8 + h]; l2 = LSE[((size_t)2 * TP + row) * 8 + h];
#pragma unroll
                    for (int g = 0; g < 3; ++g) { const u32x4* src = (const u32x4*)(OATT + ((size_t)g * TP + row) * 1024 + 16 * lane);
                        r[g][0] = __builtin_nontemporal_load(src); r[g][1] = __builtin_nontemporal_load(src + 1); }
                }
                if (do_scan) {
#pragma unroll 8
                    for (int cc = 0; cc < 16; ++cc) {
                        const size_t it = (size_t)bh * 64 + seg * 16 + cc; const size_t o = (it * 128 + k) * 256 + v;
                        *(unsigned*)(SC + o) = cvt_pk_bf16(S[0], S[1]);
                        const float dec = DEC[it * 128 + k]; const f32x2 ds = __builtin_nontemporal_load((const f32x2*)(DS + o));
                        S = S * dec + ds;
                    }
                }
                if (do_row) {
                    const float mx = fmaxf(l0, fmaxf(l1, l2));
                    float w0 = fexp2(l0 - mx), w1 = fexp2(l1 - mx), w2 = fexp2(l2 - mx); const float inv = 1.f / (w0 + w1 + w2); w0 *= inv; w1 *= inv; w2 *= inv;
                    float o[16];
#pragma unroll
                    for (int e = 0; e < 16; ++e) o[e] = 0.f;
#pragma unroll
                    for (int g = 0; g < 3; ++g) { const float wg = g == 0 ? w0 : (g == 1 ? w1 : w2);
#pragma unroll
                        for (int hh = 0; hh < 2; ++hh) { const u32x4 q = r[g][hh];
                            o[8 * hh + 0] += wg * bflo(q.x); o[8 * hh + 1] += wg * bfhi(q.x); o[8 * hh + 2] += wg * bflo(q.y); o[8 * hh + 3] += wg * bfhi(q.y);
                            o[8 * hh + 4] += wg * bflo(q.z); o[8 * hh + 5] += wg * bfhi(q.z); o[8 * hh + 6] += wg * bflo(q.w); o[8 * hh + 7] += wg * bfhi(q.w); } }
                    float ss = 0.f;
#pragma unroll
                    for (int e = 0; e < 16; ++e) ss += o[e] * o[e];
                    ss = wave_sum(ss);
                    const float rs = rsqrtf(ss * (1.f / 1024.f) + EPS);
                    const f32x4* nw = (const f32x4*)(p.att_out_norm_w + 16 * lane);
                    u32x4* dst = (u32x4*)(CAT + (size_t)row * DM + 1024 + 16 * lane);
#pragma unroll
                    for (int hh = 0; hh < 2; ++hh) { const f32x4 n0 = nw[2 * hh], n1 = nw[2 * hh + 1]; u32x4 w;
                        w.x = cvt_pk_bf16(o[8 * hh + 0] * rs * n0[0], o[8 * hh + 1] * rs * n0[1]); w.y = cvt_pk_bf16(o[8 * hh + 2] * rs * n0[2], o[8 * hh + 3] * rs * n0[3]);
                        w.z = cvt_pk_bf16(o[8 * hh + 4] * rs * n1[0], o[8 * hh + 5] * rs * n1[1]); w.w = cvt_pk_bf16(o[8 * hh + 6] * rs * n1[2], o[8 * hh + 7] * rs * n1[3]);
                        dst[hh] = w; }
                    row += stride_w;
                }
            }
            if (do_scan) { *(f32x2*)(p.out + OUT_GP + ((size_t)bh * 128 + k) * 256 + v) = S; e2 += stride_t; }
        }
    }
    {
        const float* GLAOS = (const float*)(ws + O_GLAOS); const float* ATTS = (const float*)(ws + O_ATTS); const float* ACC1 = (const float*)(ws + O_ACC1);
        for (int s = blockIdx.x * 8 + wave; s < TS; s += G * 8) {
            const int row = TP + s; const float rs1 = ((const float*)(ws + O_RSTD1))[row];
            float o[16], a[16];
#pragma unroll
            for (int q4 = 0; q4 < 4; ++q4) { const f32x4 t = *(const f32x4*)(GLAOS + (size_t)s * 1024 + 16 * lane + 4 * q4), u = *(const f32x4*)(ATTS + (size_t)s * 1024 + 16 * lane + 4 * q4);
                o[4 * q4] = t[0]; o[4 * q4 + 1] = t[1]; o[4 * q4 + 2] = t[2]; o[4 * q4 + 3] = t[3]; a[4 * q4] = u[0]; a[4 * q4 + 1] = u[1]; a[4 * q4 + 2] = u[2]; a[4 * q4 + 3] = u[3]; }
            float sg = 0.f, sa = 0.f;
#pragma unroll
            for (int e = 0; e < 16; ++e) { sg += o[e] * o[e]; sa += a[e] * a[e]; }
            sg += __shfl_xor(sg, 1); sg += __shfl_xor(sg, 2); sg += __shfl_xor(sg, 4); sg += __shfl_xor(sg, 8);
            sa = wave_sum(sa);
            const float rg = rsqrtf(sg * (1.f / 256.f) + EPS), ra = rsqrtf(sa * (1.f / 1024.f) + EPS);
            const int vcol = (16 * lane) & 255;
            f32x4 g4[4];
#pragma unroll
            for (int q4 = 0; q4 < 4; ++q4) g4[q4] = acc1_4(ACC1, s, 2048 + 16 * lane + 4 * q4);
            asm volatile("" ::: "memory");
#pragma unroll
            for (int e = 0; e < 16; e += 2) {
                const f32x4 gr4 = g4[e >> 2];
                const float g0 = gr4[e & 2] * rs1, g1 = gr4[(e & 2) + 1] * rs1;
                const float y0 = o[e] * rg * p.gla_norm_w[vcol + e] * (g0 / (1.f + __expf(-g0))), y1 = o[e + 1] * rg * p.gla_norm_w[vcol + e + 1] * (g1 / (1.f + __expf(-g1)));
                *(unsigned*)(CAT + (size_t)row * DM + 16 * lane + e) = cvt_pk_bf16(y0, y1);
                const float z0 = a[e] * ra * p.att_out_norm_w[16 * lane + e], z1 = a[e + 1] * ra * p.att_out_norm_w[16 * lane + e + 1];
                *(unsigned*)(CAT + (size_t)row * DM + 1024 + 16 * lane + e) = cvt_pk_bf16(z0, z1);
            }
        }
    }
}

__device__ __forceinline__ void gla_c_item(const P& p, LAS unsigned char* lds, int it, int tid) {
    unsigned char* ws = p.ws;
    const int wid = tid >> 6, lane = tid & 63, fr = lane & 15, fq = lane >> 4;
    const int bh = it >> 6, c = it & 63, b = bh >> 2, h = bh & 3;
    const int row0 = b * SEQ + 64 * c;
    LAS unsigned char* sQ = lds;
    LAS unsigned char* sK = lds + 16384;
    LAS unsigned char* sV = lds + 32768;
    LAS unsigned char* sS = lds + 65536;
    LAS unsigned char* sA = lds + 131072;
    LAS float* sRed = (LAS float*)(lds + 139264);
    __syncthreads();
    const bf16_t* GV = (const bf16_t*)(ws + O_GV);
#pragma unroll
    for (int i = 0; i < 4; ++i) { const int q = tid + 512 * i, row = q >> 5, ch32 = q & 31;
        const u32x4 v = *(const u32x4*)(GV + (size_t)(row0 + row) * 1024 + h * 256 + ch32 * 8);
        *(LAS u32x4*)(sV + (ch32 >> 4) * 16384 + offb(row, ch32 & 15)) = v; }
    const bf16_t* SC = (const bf16_t*)(ws + O_SC) + (size_t)it * 128 * 256;
#pragma unroll
    for (int i = 0; i < 8; ++i) { const int q = tid + 512 * i, row = q >> 5, ch32 = q & 31;
        const u32x4 v = *(const u32x4*)(SC + (size_t)row * 256 + ch32 * 8);
        *(LAS u32x4*)(sS + (ch32 >> 4) * 32768 + offb(row, ch32 & 15)) = v; }
    const bf16_t* GQ = (const bf16_t*)(ws + O_GQ); const bf16_t* GK = (const bf16_t*)(ws + O_GK); const float* BCUM = (const float*)(ws + O_BCUM);
#pragma unroll
    for (int i = 0; i < 2; ++i) { const int q = tid + 512 * i, t = q >> 4, ch = q & 15;
        const size_t go = (size_t)(row0 + t) * 512 + h * 128 + ch * 8;
        const u32x4 qr = *(const u32x4*)(GQ + go), kr = *(const u32x4*)(GK + go);
        const f32x4 b0 = *(const f32x4*)(BCUM + go), b1 = *(const f32x4*)(BCUM + go + 4);
        float e[8], ie[8];
#pragma unroll
        for (int j = 0; j < 4; ++j) { e[j] = __expf(b0[j]); e[4 + j] = __expf(b1[j]); ie[j] = __expf(-b0[j]); ie[4 + j] = __expf(-b1[j]); }
        u32x4 qo, ko;
        qo.x = cvt_pk_bf16(bflo(qr.x) * e[0], bfhi(qr.x) * e[1]); qo.y = cvt_pk_bf16(bflo(qr.y) * e[2], bfhi(qr.y) * e[3]);
        qo.z = cvt_pk_bf16(bflo(qr.z) * e[4], bfhi(qr.z) * e[5]); qo.w = cvt_pk_bf16(bflo(qr.w) * e[6], bfhi(qr.w) * e[7]);
        ko.x = cvt_pk_bf16(bflo(kr.x) * ie[0], bfhi(kr.x) * ie[1]); ko.y = cvt_pk_bf16(bflo(kr.y) * ie[2], bfhi(kr.y) * ie[3]);
        ko.z = cvt_pk_bf16(bflo(kr.z) * ie[4], bfhi(kr.z) * ie[5]); ko.w = cvt_pk_bf16(bflo(kr.w) * ie[6], bfhi(kr.w) * ie[7]);
        *(LAS u32x4*)(sQ + offb(t, ch)) = qo; *(LAS u32x4*)(sK + offb(t, ch)) = ko; }
    __syncthreads();
    { const int tb = wid >> 1;
#pragma unroll
      for (int sbi = 0; sbi < 2; ++sbi) { const int sb = (wid & 1) * 2 + sbi;
          f32x4 a = (f32x4){0.f, 0.f, 0.f, 0.f};
          if (sb <= tb) {
#pragma unroll
              for (int ks = 0; ks < 4; ++ks) { const bf16x8 kf = *(const LAS bf16x8*)(sK + offb(16 * sb + fr, 4 * ks + fq)); const bf16x8 qf = *(const LAS bf16x8*)(sQ + offb(16 * tb + fr, 4 * ks + fq)); a = mfma16(kf, qf, a); }
          }
          const int t = 16 * tb + fr;
#pragma unroll
          for (int j = 0; j < 4; ++j) { const int s = 16 * sb + 4 * fq + j; if (s > t) a[j] = 0.f; }
          u32x2 w; w.x = cvt_pk_bf16(a[0], a[1]); w.y = cvt_pk_bf16(a[2], a[3]);
          *(LAS u32x2*)(sA + t * 128 + (16 * sb + 4 * fq) * 2) = w; } }
    __syncthreads();
    f32x4 acc[2][4];
#pragma unroll
    for (int vi = 0; vi < 2; ++vi)
#pragma unroll
        for (int tb = 0; tb < 4; ++tb) acc[vi][tb] = (f32x4){0.f, 0.f, 0.f, 0.f};
    const unsigned q_ = (lane & 15) >> 2, pp = lane & 3;
    const unsigned sbase = (unsigned)(size_t)sS, vbase0 = (unsigned)(size_t)sV;
#pragma unroll
    for (int ks = 0; ks < 4; ++ks) {
        bf16x8 qf[4];
#pragma unroll
        for (int tb = 0; tb < 4; ++tb) qf[tb] = *(const LAS bf16x8*)(sQ + offb(16 * tb + fr, 4 * ks + fq));
        { const int vb = 2 * wid; const unsigned base = sbase + (vb >> 3) * 32768; const int cb = vb & 7;
            const unsigned R0 = 32 * ks + 8 * fq + q_; bf16x8 s0, s1;
            tr_read2x2(base + offb(R0, 2 * cb + (pp >> 1)) + 8 * (pp & 1), base + offb(R0 + 4, 2 * cb + (pp >> 1)) + 8 * (pp & 1),
                       base + offb(R0, 2 * cb + 2 + (pp >> 1)) + 8 * (pp & 1), base + offb(R0 + 4, 2 * cb + 2 + (pp >> 1)) + 8 * (pp & 1), s0, s1);
#pragma unroll
            for (int tb = 0; tb < 4; ++tb) { acc[0][tb] = mfma16(s0, qf[tb], acc[0][tb]); acc[1][tb] = mfma16(s1, qf[tb], acc[1][tb]); } }
    }
#pragma unroll
    for (int ks = 0; ks < 2; ++ks) {
        bf16x8 af[4];
#pragma unroll
        for (int tb = 0; tb < 4; ++tb) af[tb] = *(const LAS bf16x8*)(sA + (16 * tb + fr) * 128 + (32 * ks + 8 * fq) * 2);
        { const int vb = 2 * wid; const unsigned base = vbase0 + (vb >> 3) * 16384; const int cb = vb & 7;
            const unsigned R0 = 32 * ks + 8 * fq + q_; bf16x8 v0, v1;
            tr_read2x2(base + offb(R0, 2 * cb + (pp >> 1)) + 8 * (pp & 1), base + offb(R0 + 4, 2 * cb + (pp >> 1)) + 8 * (pp & 1),
                       base + offb(R0, 2 * cb + 2 + (pp >> 1)) + 8 * (pp & 1), base + offb(R0 + 4, 2 * cb + 2 + (pp >> 1)) + 8 * (pp & 1), v0, v1);
#pragma unroll
            for (int tb = 0; tb < 4; ++tb) { acc[0][tb] = mfma16(v0, af[tb], acc[0][tb]); acc[1][tb] = mfma16(v1, af[tb], acc[1][tb]); } }
    }
#pragma unroll
    for (int tb = 0; tb < 4; ++tb) { float ss = 0.f;
#pragma unroll
        for (int vi = 0; vi < 2; ++vi)
#pragma unroll
            for (int j = 0; j < 4; ++j) ss += acc[vi][tb][j] * acc[vi][tb][j];
        ss += __shfl_xor(ss, 16); ss += __shfl_xor(ss, 32);
        if (fq == 0) sRed[wid * 64 + 16 * tb + fr] = ss; }
    __syncthreads();
    const bf16_t* GG = (const bf16_t*)(ws + O_GG); bf16_t* CAT = (bf16_t*)(ws + O_CAT);
#pragma unroll
    for (int tb = 0; tb < 4; ++tb) { const int t = 16 * tb + fr; float tot = 0.f;
#pragma unroll
        for (int w8 = 0; w8 < 8; ++w8) tot += sRed[w8 * 64 + t];
        const float rs = rsqrtf(tot * (1.f / 256.f) + EPS);
#pragma unroll
        for (int vi = 0; vi < 2; ++vi) { const int v = 16 * (2 * wid + vi) + 4 * fq;
            const u32x2 gr = *(const u32x2*)(GG + (size_t)(row0 + t) * 1024 + h * 256 + v);
            const f32x4 nw = *(const f32x4*)(p.gla_norm_w + v);
            const float g0 = bflo(gr.x), g1 = bfhi(gr.x), g2 = bflo(gr.y), g3 = bfhi(gr.y);
            const f32x4 a = acc[vi][tb] * rs * nw;
            u32x2 w; w.x = cvt_pk_bf16(a[0] * (g0 / (1.f + __expf(-g0))), a[1] * (g1 / (1.f + __expf(-g1)))); w.y = cvt_pk_bf16(a[2] * (g2 / (1.f + __expf(-g2))), a[3] * (g3 / (1.f + __expf(-g3))));
            *(u32x2*)(CAT + (size_t)(row0 + t) * DM + h * 256 + v) = w; } }
}

__device__ __forceinline__ void sample_fin_x1(const P& p, LAS unsigned char* lds, int tid, int G) {
    unsigned char* ws = p.ws;
    const int wave = tid >> 6, lane = tid & 63;
    LAS float* red = (LAS float*)lds;
    for (int s = blockIdx.x; s < TS; s += G) {
        const int row = TP + s, c = tid * 4;
        f32x4 v = *(const f32x4*)(p.x_sample + (size_t)s * DM + c);
#pragma unroll
        for (int kp = 0; kp < 8; ++kp) v += *(const f32x4*)((const float*)(ws + O_ACCO) + ((size_t)kp * TS + s) * DM + c);
        const float ss = wave_sum((v[0] * v[0] + v[1] * v[1]) + (v[2] * v[2] + v[3] * v[3]));
        __syncthreads();
        if (lane == 0) red[wave] = ss;
        __syncthreads();
        if (tid == 0) { float tot = 0.f;
#pragma unroll
            for (int w8 = 0; w8 < 8; ++w8) tot += red[w8];
            ((float*)(ws + O_SUMS))[row] = tot; }
        u32x2 w; w.x = cvt_pk_bf16(v[0], v[1]); w.y = cvt_pk_bf16(v[2], v[3]);
        *(u32x2*)((bf16_t*)(ws + O_X1B) + (size_t)row * DM + c) = w;
        *(f32x4*)((float*)(ws + O_X1) + (size_t)row * DM + c) = v;
    }
}
__device__ __forceinline__ void sample_fin_h(const P& p, int tid, int G) {
    unsigned char* ws = p.ws;
    const float* ACCU = (const float*)(ws + O_ACCU); const float* ss2 = (const float*)(ws + O_SUMS); bf16_t* HM = (bf16_t*)(ws + O_HM);
    for (int i = blockIdx.x * NTHR + tid; i < TS * DFF / 8; i += G * NTHR) {
        const int s = i >> 10, c = (i & 1023) * 8;
        const float rs = rsqrtf(ss2[TP + s] * (1.f / DM) + EPS);
        f32x4 a = *(const f32x4*)(ACCU + (size_t)s * DFF + c), b = *(const f32x4*)(ACCU + (size_t)s * DFF + c + 4);
#pragma unroll
        for (int kp = 1; kp < 8; ++kp) { a += *(const f32x4*)(ACCU + ((size_t)kp * TS + s) * DFF + c); b += *(const f32x4*)(ACCU + ((size_t)kp * TS + s) * DFF + c + 4); }
        a = a * rs; b = b * rs;
#pragma unroll
        for (int j = 0; j < 4; ++j) { a[j] = fmaxf(a[j], 0.f); a[j] *= a[j]; b[j] = fmaxf(b[j], 0.f); b[j] *= b[j]; }
        u32x4 w; w.x = cvt_pk_bf16(a[0], a[1]); w.y = cvt_pk_bf16(a[2], a[3]); w.z = cvt_pk_bf16(b[0], b[1]); w.w = cvt_pk_bf16(b[2], b[3]);
        *(u32x4*)(HM + (size_t)(TP + s) * DFF + c) = w;
    }
}

__device__ __forceinline__ void phase8(const P& p, int tid, int base, int cnt) {
    const int wave = tid >> 6, lane = tid & 63;
    const bf16_t* X2B = (const bf16_t*)(p.ws + O_CAT);
    const int m1 = base + cnt;
    for (int mb = base + wave; mb < m1; mb += 32) {
        u32x4 raw[4][4];
#pragma unroll
        for (int q = 0; q < 4; ++q) { const int m = mb + q * 8;
            if (m < m1) { const u32x4* xr = (const u32x4*)(X2B + (size_t)m * DM);
#pragma unroll
                for (int j = 0; j < 4; ++j) raw[q][j] = __builtin_nontemporal_load(xr + lane + 64 * j); } }
        asm volatile("" ::: "memory");
#pragma unroll
        for (int q = 0; q < 4; ++q) { const int m = mb + q * 8;
            if (m < m1) {
                float v[32]; float s = 0.f;
#pragma unroll
                for (int j = 0; j < 4; ++j) { const u32x4 r = raw[q][j];
                    v[8 * j + 0] = bflo(r.x); v[8 * j + 1] = bfhi(r.x); v[8 * j + 2] = bflo(r.y); v[8 * j + 3] = bfhi(r.y);
                    v[8 * j + 4] = bflo(r.z); v[8 * j + 5] = bfhi(r.z); v[8 * j + 6] = bflo(r.w); v[8 * j + 7] = bfhi(r.w); }
#pragma unroll
                for (int e = 0; e < 32; ++e) s += v[e] * v[e];
                s = wave_sum(s);
                const float rs = rsqrtf(s * (1.f / DM) + EPS);
                float* yr = p.out + OUT_YP + (size_t)m * DM;
#pragma unroll
                for (int j = 0; j < 4; ++j) { const int c = (lane + 64 * j) * 8;
                    const f32x4 w0 = *(const f32x4*)(p.final_norm_w + c), w1 = *(const f32x4*)(p.final_norm_w + c + 4);
                    __builtin_nontemporal_store((f32x4){v[8 * j] * rs * w0[0], v[8 * j + 1] * rs * w0[1], v[8 * j + 2] * rs * w0[2], v[8 * j + 3] * rs * w0[3]}, (f32x4*)(yr + c));
                    __builtin_nontemporal_store((f32x4){v[8 * j + 4] * rs * w1[0], v[8 * j + 5] * rs * w1[1], v[8 * j + 6] * rs * w1[2], v[8 * j + 7] * rs * w1[3]}, (f32x4*)(yr + c + 4)); }
            } }
    }
}

#define XB_TMO      128
#define XB_XCNT(j)  (256  + 64 * (j))
#define XB_XSUB(j)  (1280 + 64 * (j))
#define XB_XGEN(j)  (2304 + 64 * (j))
#define XB_TOP      3328
#define XB_TOPGEN   3392
#define XCD_BAR_WORDS 3456
#define XB_SPIN_CAP (1u << 18)
__device__ __forceinline__ unsigned xb_ld(unsigned* p)              { return __hip_atomic_load(p, __ATOMIC_RELAXED, __HIP_MEMORY_SCOPE_AGENT); }
__device__ __forceinline__ unsigned xb_add(unsigned* p, unsigned v) { return __hip_atomic_fetch_add(p, v, __ATOMIC_RELAXED, __HIP_MEMORY_SCOPE_AGENT); }
__device__ __forceinline__ unsigned xb_xcc_id() { return (unsigned)__builtin_amdgcn_s_getreg((3 << 11) | 20) & 0xFu; }
#define XB_SPIN(cond, bar) do { unsigned _sp = 0; while (cond) { __builtin_amdgcn_s_sleep(1); \
    if ((++_sp & 255u) == 0u) { if (xb_ld(&(bar)[XB_TMO])) break; if (_sp > XB_SPIN_CAP) { atomicAdd(&(bar)[XB_TMO], 1u); break; } } } } while (0)
struct XcdBarrier { unsigned* bar; unsigned x; volatile LAS unsigned* st; };
__device__ __forceinline__ XcdBarrier xcd_barrier_post(unsigned* bar, volatile LAS unsigned* st) {
    XcdBarrier b; b.bar = bar; b.x = xb_xcc_id(); b.st = st;
    if (threadIdx.x == 0) (void)xb_add(&bar[XB_XCNT(b.x)], 1u);
    return b;
}
__device__ __forceinline__ void xcd_barrier_complete(unsigned* bar, unsigned x, unsigned& nloc, unsigned& nx) {
    const unsigned G = gridDim.x * gridDim.y * gridDim.z;
    unsigned sum, cnt, mine, sp = 0u;
    for (;;) {
        sum = 0u; cnt = 0u; mine = 0u;
#pragma unroll
        for (unsigned j = 0; j < 16; ++j) { const unsigned c = xb_ld(&bar[XB_XCNT(j)]); sum += c; cnt += (c > 0u) ? 1u : 0u; mine = (j == x) ? c : mine; }
        if (sum == G) break;
        __builtin_amdgcn_s_sleep(1);
        if ((++sp & 255u) == 0u) { if (xb_ld(&bar[XB_TMO])) break; if (sp > XB_SPIN_CAP) { atomicAdd(&bar[XB_TMO], 1u); break; } }
    }
    nloc = mine > 0u ? mine : 1u; nx = cnt > 0u ? cnt : 1u;
}
__device__ __forceinline__ void xcd_barrier(const XcdBarrier& b) {
    asm volatile("s_waitcnt vmcnt(0)" ::: "memory");
    __syncthreads();
    if (threadIdx.x == 0) {
        unsigned* bar = b.bar;
        __builtin_amdgcn_s_waitcnt(0);
        unsigned nloc = b.st[0], nx = b.st[1];
        if (nloc == 0u) { xcd_barrier_complete(bar, b.x, nloc, nx); b.st[0] = nloc; b.st[1] = nx; }
        const unsigned old = xb_add(&bar[XB_XSUB(b.x)], 1u);
        const unsigned gen = old / nloc;
        if (old + 1u == (gen + 1u) * nloc) {
            __builtin_amdgcn_fence(__ATOMIC_RELEASE, "agent");
            asm volatile("s_waitcnt vmcnt(0)" ::: "memory");
            const unsigned og = xb_add(&bar[XB_TOP], 1u);
            const unsigned tg = og / nx;
            if (og + 1u == (tg + 1u) * nx) xb_add(&bar[XB_TOPGEN], 1u);
            else XB_SPIN(xb_ld(&bar[XB_TOPGEN]) == tg, bar);
            __builtin_amdgcn_fence(__ATOMIC_ACQUIRE, "agent");
            xb_add(&bar[XB_XGEN(b.x)], 1u);
            asm volatile("s_waitcnt vmcnt(0)" ::: "memory");
        } else {
            XB_SPIN(xb_ld(&bar[XB_XGEN(b.x)]) == gen, bar);
            __builtin_amdgcn_fence(__ATOMIC_ACQUIRE, "agent");
            asm volatile("s_waitcnt vmcnt(0)" ::: "memory");
        }
    }
    __syncthreads();
}

__global__ void __launch_bounds__(NTHR) fwd_megakernel(P p) {
    extern __shared__ __attribute__((aligned(16))) unsigned char smem[];
    LAS unsigned char* lds = (LAS unsigned char*)smem;
    cg::grid_group grid = cg::this_grid();
    const int G = gridDim.x;
    unsigned char* ws = p.ws;
    if (threadIdx.x < 4) ((LAS unsigned*)(lds + LDS_BYTES - 16))[threadIdx.x] = 0u;
    __syncthreads();
    XcdBarrier xbar = xcd_barrier_post((unsigned*)(ws + O_BAR), (volatile LAS unsigned*)(lds + LDS_BYTES - 16));
    if (p.ws == nullptr) grid.sync();
#define GRID_SYNC() xcd_barrier(xbar)

    for (int rep = 0; rep < NREP(1); ++rep) { phase0(p, lds, fresh_tid(), G); __syncthreads(); }
    GRID_SYNC();

    {
        pg8::StaticOrder S; S.init((const bf16_t*)(ws + O_XB), (const bf16_t*)(ws + O_BT1), TP, N1, DM, G, (int)blockIdx.x);
        pg8::PieceOrder SP; SP.init((const bf16_t*)(ws + O_XB) + (size_t)TP * DM, (const bf16_t*)(ws + O_BT1), N1, DM, 256, G, (int)blockIdx.x);
        pg8::CombOrder SC; SC.init(S, SP, DM / 64, 4);
        EpiBoth<Epi1> E{Epi1{p}, EpiPartP{(float*)(ws + O_ACC1), N1}};
        pg8::gemm_phase<EpiBoth<Epi1>, pg8::CombOrder>(lds, pg8::Gemm{DM, DM / 64}, SC, E);
        for (int rep = 0; rep < NREP(4); ++rep) phase1_skinny(p, lds, fresh_tid(), G);
    }
    GRID_SYNC();

    {
        { const int t0 = fresh_tid(); const int w = __builtin_amdgcn_readfirstlane(t0 >> 6);
          __syncthreads();
          if (w < 4) { for (int wi = w * G + blockIdx.x; wi < 1024; wi += G * 4) attn_sample_item(p, wi, t0 & 63); }
          else side_transposes(p, lds, w - 4, t0 & 63, G); }
        for (int rep = 0; rep < NREP(16); ++rep) { const int t0 = fresh_tid(); for (int it = blockIdx.x; it < 256; it += G) gla_sample_item(p, lds, it, t0); }
        for (int rep = 0; rep < NREP(32); ++rep) { const int t0 = fresh_tid(); for (int it = blockIdx.x; it < 512; it += G) gla_a_item(p, lds, it, t0); }
        for (int rep = 0; rep < NREP(64); ++rep) attn_prompt_loop(p, lds, fresh_tid(), G);
    }
    GRID_SYNC();

    for (int rep = 0; rep < NREP(128); ++rep) phase3(p, fresh_tid(), G);
    GRID_SYNC();

    {
        const int t0 = fresh_tid(); const int c = (int)blockIdx.x;
        const bool part = (G == 256);
        const int nmine = part ? (c < 64 ? 1 : (c < 128 ? 3 : 2)) : (c < 512 ? (511 - c) / G + 1 : 0);
#pragma unroll 1
        for (int k = 0; k < nmine; ++k) {
            int it;
            if (!part) it = c + k * G;
            else if (c < 64) it = c;
            else it = (k < 2) ? 64 + (c - 64) * 2 + k : 448 + (c - 64);
            gla_c_item(p, lds, it, t0);
        }
    }
    __syncthreads();
    {
        pg8::PieceOrder SP; SP.init((const bf16_t*)(ws + O_CAT) + (size_t)TP * DM, (const bf16_t*)(ws + O_BTO), DM, DM, 256, G, (int)blockIdx.x);
        EpiPart EA{(float*)(ws + O_ACCO), DM};
        pg8::gemm_phase<EpiPart, pg8::PieceOrder>(lds, pg8::Gemm{DM, 4}, SP, EA);
    }
    GRID_SYNC();

    {
        pg8::StaticOrder S; S.init((const bf16_t*)(ws + O_CAT), (const bf16_t*)(ws + O_BTO), TP, DM, DM, G, (int)blockIdx.x);
        EpiO E{p};
        pg8::gemm_phase<EpiO, pg8::StaticOrder>(lds, pg8::Gemm{DM, DM / 64}, S, E);
        sample_fin_x1(p, lds, fresh_tid(), G);
    }
    GRID_SYNC();

    {
        pg8::StaticOrder S; S.init((const bf16_t*)(ws + O_X1B), (const bf16_t*)(ws + O_BTU), TP, DFF, DM, G, (int)blockIdx.x);
        pg8::PieceOrder SP; SP.init((const bf16_t*)(ws + O_X1B) + (size_t)TP * DM, (const bf16_t*)(ws + O_BTU), DFF, DM, 256, G, (int)blockIdx.x);
        pg8::CombOrder SC; SC.init(S, SP, DM / 64, 4);
        EpiBoth<EpiU> E{EpiU{p}, EpiPartP{(float*)(ws + O_ACCU), DFF}};
        pg8::gemm_phase<EpiBoth<EpiU>, pg8::CombOrder>(lds, pg8::Gemm{DM, DM / 64}, SC, E);
    }
    GRID_SYNC();

    {
        pg8::StaticOrder S; S.init((const bf16_t*)(ws + O_HM), (const bf16_t*)(ws + O_BTD), TP, DM, DFF, G, (int)blockIdx.x);
        EpiD E{p};
        for (int rep = 0; rep < NREP(2048); ++rep) pg8::gemm_phase<EpiD, pg8::StaticOrder>(lds, pg8::Gemm{DFF, DFF / 64}, S, E);
        sample_fin_h(p, fresh_tid(), G);
    }
    GRID_SYNC();

    {
        pg8::PieceOrder SP; SP.init((const bf16_t*)(ws + O_HM) + (size_t)TP * DFF, (const bf16_t*)(ws + O_BTD), DM, DFF, 512, G, (int)blockIdx.x);
        EpiPart EA{(float*)(ws + O_ACCD), DM};
        pg8::gemm_phase<EpiPart, pg8::PieceOrder>(lds, pg8::Gemm{DFF, 8}, SP, EA);
        int base, cnt; const int c = (int)blockIdx.x;
        if (G == 256) { if (c < 128) { base = c * 20; cnt = 20; } else { base = 2560 + (c - 128) * 44; cnt = 44; } }
        else { const int per = (TP + G - 1) / G; base = c * per; cnt = base + per <= TP ? per : (TP > base ? TP - base : 0); }
        phase8(p, fresh_tid(), base, cnt);
    }
    GRID_SYNC();

    if (REP_MASK & 4096) { for (int rep = 0; rep < 10; ++rep) GRID_SYNC(); }
    {
        const int tid = fresh_tid(), wave = tid >> 6, lane = tid & 63;
        LAS float* red = (LAS float*)lds;
        for (int s = blockIdx.x; s < TS; s += G) {
            const int c = tid * 4;
            f32x4 v = *(const f32x4*)((const float*)(ws + O_X1) + (size_t)(TP + s) * DM + c);
#pragma unroll
            for (int kp = 0; kp < 16; ++kp) v += *(const f32x4*)((const float*)(ws + O_ACCD) + ((size_t)kp * TS + s) * DM + c);
            float ss = wave_sum((v[0] * v[0] + v[1] * v[1]) + (v[2] * v[2] + v[3] * v[3]));
            __syncthreads();
            if (lane == 0) red[wave] = ss;
            __syncthreads();
            float tot = 0.f;
#pragma unroll
            for (int w8 = 0; w8 < 8; ++w8) tot += red[w8];
            const float rs = rsqrtf(tot * (1.f / DM) + EPS);
            *(f32x4*)(p.out + OUT_YS + (size_t)s * DM + c) = v * rs * *(const f32x4*)(p.final_norm_w + c);
        }
    }
}

extern "C" void kernel_launch(void* const* d_in, const int* in_sizes, int n_in, void* d_out, int out_size, void* d_ws, size_t ws_size, hipStream_t stream) {
    static int grid_blocks = 0;
    if (!grid_blocks) {
        int dev = 0, cus = 0, per_cu = 0;
        hipGetDevice(&dev);
        hipDeviceGetAttribute(&cus, hipDeviceAttributeMultiprocessorCount, dev);
        hipFuncSetAttribute((const void*)fwd_megakernel, hipFuncAttributeMaxDynamicSharedMemorySize, LDS_BYTES);
        hipOccupancyMaxActiveBlocksPerMultiprocessor(&per_cu, (const void*)fwd_megakernel, NTHR, LDS_BYTES);
        if (per_cu < 1) per_cu = 1;
        grid_blocks = cus * per_cu;
        if (ws_size < WS_END) fprintf(stderr, "workspace too small: %zu < %zu\n", ws_size, (size_t)WS_END);
    }
    P p{};
    p.x_prompt = (const float*)d_in[0]; p.x_sample = (const float*)d_in[1]; p.cache_k = (const float*)d_in[2]; p.cache_v = (const float*)d_in[3];
    p.state_gla = (const float*)d_in[4]; p.attn_norm_w = (const float*)d_in[5]; p.w_in = (const float*)d_in[6]; p.w_gk_up = (const float*)d_in[7];
    p.b_gk = (const float*)d_in[8]; p.gla_norm_w = (const float*)d_in[9]; p.att_out_norm_w = (const float*)d_in[10]; p.w_out = (const float*)d_in[11];
    p.ffn_norm_w = (const float*)d_in[12]; p.w_up = (const float*)d_in[13]; p.w_down = (const float*)d_in[14]; p.final_norm_w = (const float*)d_in[15];
    p.out = (float*)d_out; p.ws = (unsigned char*)d_ws;
    hipMemsetAsync((char*)d_ws + O_BAR, 0, 16384, stream);
    void* args[] = {&p};
    hipError_t e = hipLaunchCooperativeKernel((const void*)fwd_megakernel, dim3(grid_blocks), dim3(NTHR), args, LDS_BYTES, stream);
    if (e != hipSuccess) fprintf(stderr, "cooperative launch failed: %s (grid %d)\n", hipGetErrorString(e), grid_blocks);
}
```

```cpp
#include <hip/hip_runtime.h>
#include <hip/hip_cooperative_groups.h>
#include <cstdio>
namespace cg = cooperative_groups;

#define LAS __attribute__((address_space(3)))
typedef unsigned short bf16_t;
typedef short bf16x8 __attribute__((ext_vector_type(8)));
typedef float f32x4 __attribute__((ext_vector_type(4)));
typedef float f32x2 __attribute__((ext_vector_type(2)));
typedef unsigned u32x4 __attribute__((ext_vector_type(4)));
typedef unsigned u32x2 __attribute__((ext_vector_type(2)));

constexpr int DM = 2048, TP = 8192, TS = 128, MT = TP + TS, SEQ = 4096, DFF = 8192;
constexpr int N1 = 6144;
constexpr float EPS = 1e-6f;
constexpr float LOG2E = 1.4426950408889634f;
constexpr int NTHR = 512;
constexpr int LDS_BYTES = 147456;
#ifndef PH_MASK
#define PH_MASK 0x1ff
#endif
#ifndef REP_MASK
#define REP_MASK 0
#endif
#define NREP(b) ((REP_MASK & (b)) ? 2 : 1)

constexpr size_t OUT_YP = 0, OUT_YS = 16777216, OUT_KW = 17039360, OUT_VW = 21233664, OUT_GP = 25427968,
                 OUT_KN = 25690112, OUT_VN = 25821184, OUT_GS = 25952256;

constexpr size_t al(size_t x) { return (x + 255) & ~(size_t)255; }
constexpr size_t O_BAR = 0;
constexpr size_t O_SUMS = 16384;
constexpr size_t O_RSTD1 = O_SUMS + al((size_t)MT * 4);
constexpr size_t O_GLR = O_RSTD1 + al((size_t)MT * 4);
constexpr size_t O_XB = O_GLR + al((size_t)MT * 16 * 4);
constexpr size_t O_BT1 = O_XB + al((size_t)MT * DM * 2);
constexpr size_t O_BTG = O_BT1 + al((size_t)N1 * DM * 2);
constexpr size_t O_BTO = O_BTG + al((size_t)16 * DM * 2);
constexpr size_t O_BTU = O_BTO + al((size_t)DM * DM * 2);
constexpr size_t O_BTD = O_BTU + al((size_t)DFF * DM * 2);
constexpr size_t O_GQ = O_BTD + al((size_t)DM * DFF * 2);
constexpr size_t O_GK = O_GQ + al((size_t)MT * 512 * 2);
constexpr size_t O_GV = O_GK + al((size_t)MT * 512 * 2);
constexpr size_t O_GG = O_GV + al((size_t)MT * 1024 * 2);
constexpr size_t O_AQ = O_GG + al((size_t)MT * 1024 * 2);
constexpr size_t O_AK = O_AQ + al((size_t)MT * 1024 * 2);
constexpr size_t O_AV = O_AK + al((size_t)MT * 1024 * 2);
constexpr size_t O_BCUM = O_AV + al((size_t)MT * 1024 * 2);
constexpr size_t O_DS = O_BCUM + al((size_t)TP * 512 * 4);
constexpr size_t O_SC = O_DS + al((size_t)512 * 128 * 256 * 4);
constexpr size_t O_DEC = O_SC + al((size_t)512 * 128 * 256 * 2);
constexpr size_t O_OATT = O_DEC + al((size_t)512 * 128 * 4);
constexpr size_t O_LSE = O_OATT + al((size_t)3 * TP * 1024 * 2);
constexpr size_t O_ATTS = O_LSE + al((size_t)3 * TP * 8 * 4);
constexpr size_t O_GLAOS = O_ATTS + al((size_t)TS * 1024 * 4);
constexpr size_t O_CAT = O_GLAOS + al((size_t)TS * 1024 * 4);
constexpr size_t O_X1 = O_CAT + al((size_t)MT * DM * 2);
constexpr size_t O_X1B = O_X1 + al((size_t)MT * DM * 4);
constexpr size_t O_HM = O_X1B + al((size_t)MT * DM * 2);
constexpr size_t O_ACC1 = O_HM + al((size_t)MT * DFF * 2);
constexpr size_t O_ACCO = O_ACC1 + al((size_t)8 * TS * N1 * 4);
constexpr size_t O_ACCU = O_ACCO + al((size_t)8 * TS * DM * 4);
constexpr size_t O_ACCD = O_ACCU + al((size_t)8 * TS * DFF * 4);
constexpr size_t WS_END = O_ACCD + al((size_t)32 * TS * DM * 4) + (size_t)4 * 1024 * 1024;
__device__ __forceinline__ f32x4 acc1_4(const float* ACC1, int srow, int col) {
    f32x4 s = *(const f32x4*)(ACC1 + (size_t)srow * N1 + col);
#pragma unroll
    for (int kp = 1; kp < 8; ++kp) s += *(const f32x4*)(ACC1 + ((size_t)kp * TS + srow) * N1 + col);
    return s;
}
__device__ __forceinline__ float acc1_1(const float* ACC1, int srow, int col) {
    float s = ACC1[(size_t)srow * N1 + col];
#pragma unroll
    for (int kp = 1; kp < 8; ++kp) s += ACC1[((size_t)kp * TS + srow) * N1 + col];
    return s;
}

struct P {
    const float *x_prompt, *x_sample, *cache_k, *cache_v, *state_gla, *attn_norm_w, *w_in, *w_gk_up, *b_gk, *gla_norm_w,
        *att_out_norm_w, *w_out, *ffn_norm_w, *w_up, *w_down, *final_norm_w;
    float* out;
    unsigned char* ws;
};

__device__ __forceinline__ unsigned cvt_pk_bf16(float lo, float hi) { unsigned r; asm volatile("v_cvt_pk_bf16_f32 %0, %1, %2" : "=v"(r) : "v"(lo), "v"(hi)); return r; }
__device__ __forceinline__ bf16_t f2bf(float f) { return (bf16_t)(cvt_pk_bf16(f, 0.f) & 0xffffu); }
__device__ __forceinline__ float bflo(unsigned u) { return __uint_as_float(u << 16); }
__device__ __forceinline__ float bfhi(unsigned u) { return __uint_as_float(u & 0xffff0000u); }
__device__ __forceinline__ float bf2f(bf16_t b) { return __uint_as_float(((unsigned)b) << 16); }
__device__ __forceinline__ float wave_sum(float v) {
#pragma unroll
    for (int o = 1; o < 64; o <<= 1) v += __shfl_xor(v, o);
    return v;
}
__device__ __forceinline__ int fresh_tid() { int t = threadIdx.x; asm volatile("" : "+v"(t)); return t; }
__device__ __forceinline__ float fexp2(float x) { return __builtin_amdgcn_exp2f(x); }
__device__ __forceinline__ float flog2(float x) { return __builtin_amdgcn_logf(x); }
__device__ __forceinline__ unsigned offb(unsigned row, unsigned ch) { return 256u * row + 16u * (ch ^ (((row & 3u) << 2) | ((row >> 2) & 3u))); }
__device__ __forceinline__ bf16x8 tr_read2(unsigned a0, unsigned a1) {
    u32x2 r0, r1;
    asm volatile("ds_read_b64_tr_b16 %0, %2\n\tds_read_b64_tr_b16 %1, %3\n\ts_waitcnt lgkmcnt(0)" : "=&v"(r0), "=&v"(r1) : "v"(a0), "v"(a1) : "memory");
    u32x4 r; r.x = r0.x; r.y = r0.y; r.z = r1.x; r.w = r1.y;
    return __builtin_bit_cast(bf16x8, r);
}
__device__ __forceinline__ void tr_read_4x2(const unsigned (&a)[4], bf16x8 (&out)[4]) {
    u32x2 r[8];
    asm volatile(
        "ds_read_b64_tr_b16 %0, %8\n\tds_read_b64_tr_b16 %1, %8 offset:4096\n\t"
        "ds_read_b64_tr_b16 %2, %9\n\tds_read_b64_tr_b16 %3, %9 offset:4096\n\t"
        "ds_read_b64_tr_b16 %4, %10\n\tds_read_b64_tr_b16 %5, %10 offset:4096\n\t"
        "ds_read_b64_tr_b16 %6, %11\n\tds_read_b64_tr_b16 %7, %11 offset:4096\n\t"
        "s_waitcnt lgkmcnt(0)"
        : "=&v"(r[0]), "=&v"(r[1]), "=&v"(r[2]), "=&v"(r[3]), "=&v"(r[4]), "=&v"(r[5]), "=&v"(r[6]), "=&v"(r[7])
        : "v"(a[0]), "v"(a[1]), "v"(a[2]), "v"(a[3])
        : "memory");
#pragma unroll
    for (int i = 0; i < 4; ++i) { u32x4 t; t.x = r[2 * i].x; t.y = r[2 * i].y; t.z = r[2 * i + 1].x; t.w = r[2 * i + 1].y; out[i] = __builtin_bit_cast(bf16x8, t); }
}
__device__ __forceinline__ void tr_read2x2(unsigned a0, unsigned a1, unsigned b0, unsigned b1, bf16x8& fa, bf16x8& fb) {
    u32x2 r0, r1, r2, r3;
    asm volatile("ds_read_b64_tr_b16 %0, %4\n\tds_read_b64_tr_b16 %1, %5\n\tds_read_b64_tr_b16 %2, %6\n\tds_read_b64_tr_b16 %3, %7\n\ts_waitcnt lgkmcnt(0)"
                 : "=&v"(r0), "=&v"(r1), "=&v"(r2), "=&v"(r3) : "v"(a0), "v"(a1), "v"(b0), "v"(b1) : "memory");
    u32x4 x; x.x = r0.x; x.y = r0.y; x.z = r1.x; x.w = r1.y; fa = __builtin_bit_cast(bf16x8, x);
    u32x4 y; y.x = r2.x; y.y = r2.y; y.z = r3.x; y.w = r3.y; fb = __builtin_bit_cast(bf16x8, y);
}
__device__ __forceinline__ bf16x8 pack8(f32x4 a, f32x4 b) {
    u32x4 r; r.x = cvt_pk_bf16(a[0], a[1]); r.y = cvt_pk_bf16(a[2], a[3]); r.z = cvt_pk_bf16(b[0], b[1]); r.w = cvt_pk_bf16(b[2], b[3]);
    return __builtin_bit_cast(bf16x8, r);
}
__device__ __forceinline__ f32x4 mfma16(bf16x8 a, bf16x8 b, f32x4 c) { return __builtin_amdgcn_mfma_f32_16x16x32_bf16(a, b, c, 0, 0, 0); }

namespace pg8 {
constexpr int BM = 256, BK = 64, HALF = 128, HTB = HALF * BK * 2, STAGE_BYTES = 8 * HTB, NXCD = 8, WGM = 8;
__host__ __device__ __forceinline__ int lds_byte(int r, int c) { const int st = (r >> 4) * 2 + (c >> 5), rr = r & 15, cc = c & 31, ob = rr * 64 + cc * 2; return st * 1024 + (ob ^ (((ob >> 9) & 1) << 5)); }
__host__ __device__ __forceinline__ void stage_rc(int b, int& R, int& C) { const int st = b / 1024, sb = b % 1024, swz = sb ^ (((sb >> 9) & 1) << 5); R = (st >> 1) * 16 + swz / 64; C = (st & 1) * 32 + (swz % 64) / 2; }
__host__ __device__ __forceinline__ int perm32(int rho) { const int n = rho >> 4, i = rho & 15; return 8 * (i >> 2) + 4 * n + (i & 3); }
struct Unit { int pm, pn; const char* A; const char* B; int nt, kind, ord; };
struct Gemm { int ld, nt; };
struct StaticOrder {
    int nM, nN, nwg, G, c; const char* Ab; const char* Bb; size_t tstep;
    __device__ void init(const bf16_t* A, const bf16_t* Bt, int M, int N, int ld, int G_, int c_) { nM = M / BM; nN = N / BM; nwg = nM * nN; G = G_; c = c_; Ab = (const char*)A; Bb = (const char*)Bt; tstep = (size_t)BM * ld * 2; }
    __device__ bool next(int i, Unit& u) const {
        const long L = (long)i * G + c; if (L >= nwg) return false;
        int wgid = (int)L; { const int q = nwg / NXCD, r = nwg % NXCD, xcd = wgid % NXCD, off = wgid / NXCD; wgid = (xcd < r ? xcd * (q + 1) : r * (q + 1) + (xcd - r) * q) + off; }
        const int nig = WGM * nN, gid = wgid / nig, fm = gid * WGM, gsz = (nM - fm) < WGM ? (nM - fm) : WGM;
        u.pm = fm + ((wgid % nig) % gsz); u.pn = (wgid % nig) / gsz; u.A = Ab + (size_t)u.pm * tstep; u.B = Bb + (size_t)u.pn * tstep; u.nt = 0; u.kind = 0; return true;
    }
};
struct PieceOrder {
    int nN, nK, G, c; const char* Ab; const char* Bb; size_t tstep, kbytes;
    __device__ void init(const bf16_t* A, const bf16_t* Bt, int N, int ld, int klen, int G_, int c_) { nN = N / BM; nK = ld / klen; G = G_; c = c_; Ab = (const char*)A; Bb = (const char*)Bt; tstep = (size_t)BM * ld * 2; kbytes = (size_t)klen * 2; }
    __device__ bool next(int i, Unit& u) const {
        const int L = i * G + c; if (L >= nN * nK) return false;
        u.pn = L % nN; u.pm = L / nN; u.A = Ab + (size_t)u.pm * kbytes; u.B = Bb + (size_t)u.pn * tstep + (size_t)u.pm * kbytes; u.nt = 0; u.kind = 1; return true;
    }
};

struct CombOrder {
    StaticOrder s; PieceOrder p; int ns, nt_full, nt_piece;
    __device__ void init(const StaticOrder& s_, const PieceOrder& p_, int nt_full_, int nt_piece_) { s = s_; p = p_; nt_full = nt_full_; nt_piece = nt_piece_; ns = s.c < s.nwg ? (s.nwg - 1 - s.c) / s.G + 1 : 0; }
    __device__ bool next(int i, Unit& u) const {
        if (i < ns) { s.next(i, u); u.nt = nt_full; u.ord = i; return true; }
        if (p.next(i - ns, u)) { u.nt = nt_piece; u.ord = i; return true; }
        return false;
    }
};

template <class Epi, class Sched>
__device__ __forceinline__ void gemm_phase(LAS unsigned char* lds, const Gemm g, const Sched& S, const Epi& E) {
    const int tid = fresh_tid(), wid = __builtin_amdgcn_readfirstlane(tid >> 6), lane = tid & 63, wr = wid >> 2, wc = wid & 3, fr = lane & 15, fq = lane >> 4;
    const int K = g.ld;
    unsigned voffA[2], voffB[2];
#pragma unroll
    for (int i = 0; i < 2; ++i) { int R, C; stage_rc(tid * 16 + i * 8192, R, C); const int Rb = Epi::PERM ? ((R & ~31) + perm32(R & 31)) : R;
        voffA[i] = (unsigned)(R * K + C) * 2u; voffB[i] = (unsigned)(Rb * K + C) * 2u; }
    const size_t kstep = (size_t)(BK * 2);
    const size_t hstep = (size_t)HALF * K * 2;
    const unsigned ldsw = (unsigned)wid * 1024u;
    const int aoff = lds_byte(wr * 64 + fr, fq * 8), boff = lds_byte(wc * 32 + fr, fq * 8);
#define PG8_SA(b, h) (((b) * 2 + (h)) * HTB)
#define PG8_SB(b, h) ((4 + (b) * 2 + (h)) * HTB)
#define PG8_STAGE(bufoff, gbase, voff) do { _Pragma("unroll") for (int _i = 0; _i < 2; ++_i) \
        __builtin_amdgcn_global_load_lds((const unsigned*)((const char*)(gbase) + (voff)[_i]), (LAS unsigned*)(lds + (bufoff) + ldsw + _i * 8192), 16, 0, 0); } while (0)
#define PG8_LDA(dst, b, h) do { _Pragma("unroll") for (int m = 0; m < 4; ++m) _Pragma("unroll") for (int k = 0; k < 2; ++k) dst[m][k] = *(const LAS bf16x8*)(lds + PG8_SA(b, h) + aoff + m * 2048 + k * 1024); } while (0)
#define PG8_LDB(dst, b, h) do { _Pragma("unroll") for (int n = 0; n < 2; ++n) _Pragma("unroll") for (int k = 0; k < 2; ++k) dst[n][k] = *(const LAS bf16x8*)(lds + PG8_SB(b, h) + boff + n * 2048 + k * 1024); } while (0)
#define PG8_MMA(ai, bj, At, Bt) do { __builtin_amdgcn_s_setprio(1); _Pragma("unroll") for (int m = 0; m < 4; ++m) _Pragma("unroll") for (int n = 0; n < 2; ++n) _Pragma("unroll") for (int k = 0; k < 2; ++k) \
        acc[ai][bj][m][n] = __builtin_amdgcn_mfma_f32_16x16x32_bf16(Bt[n][k], At[m][k], acc[ai][bj][m][n], 0, 0, 0); __builtin_amdgcn_s_setprio(0); } while (0)
#define PG8_WAIT_V(n) asm volatile("s_waitcnt vmcnt(" #n ")" ::: "memory")
#define PG8_WAIT_L(n) asm volatile("s_waitcnt lgkmcnt(" #n ")" ::: "memory")
#define PG8_BAR __builtin_amdgcn_s_barrier()
#define PG8_SCHED __builtin_amdgcn_sched_barrier(0)
    Unit cur, nxt; int ui = 0;
    if (!S.next(0, cur)) return;
    int nt = cur.nt ? cur.nt : g.nt;
    f32x4 acc[2][2][4][2];
#pragma unroll
    for (int a = 0; a < 2; ++a)
#pragma unroll
        for (int b = 0; b < 2; ++b)
#pragma unroll
            for (int m = 0; m < 4; ++m)
#pragma unroll
                for (int n = 0; n < 2; ++n) acc[a][b][m][n] = (f32x4){0.f, 0.f, 0.f, 0.f};
    bf16x8 At[4][2], B0[2][2], B1[2][2];
    const char* cA = cur.A; const char* cB = cur.B;
    PG8_STAGE(PG8_SB(0, 0), cB, voffB); PG8_STAGE(PG8_SA(0, 0), cA, voffA); PG8_STAGE(PG8_SB(0, 1), cB + hstep, voffB); PG8_STAGE(PG8_SA(0, 1), cA + hstep, voffA);
    if (wr == 1) PG8_BAR;
    PG8_WAIT_V(4); PG8_BAR;
    PG8_STAGE(PG8_SB(1, 0), cB + kstep, voffB); PG8_STAGE(PG8_SA(1, 0), cA + kstep, voffA); PG8_STAGE(PG8_SB(1, 1), cB + hstep + kstep, voffB);
    PG8_WAIT_V(6); PG8_BAR;
    for (;;) {
        const bool has_next = S.next(ui + 1, nxt);
        const char* nA = has_next ? nxt.A : cA; const char* nB = has_next ? nxt.B : cB;
        for (int t = 0; t < nt; t += 2) {
            const bool last = (t == nt - 2);
            const char* a1 = cA + (size_t)(t + 1) * kstep;
            const char* a2 = last ? nA : cA + (size_t)(t + 2) * kstep; const char* b2 = last ? nB : cB + (size_t)(t + 2) * kstep;
            const char* a3 = a2 + kstep; const char* b3 = b2 + kstep;
            PG8_LDB(B0, 0, 0); PG8_SCHED; PG8_LDA(At, 0, 0); PG8_STAGE(PG8_SA(1, 1), a1 + hstep, voffA);
            PG8_WAIT_L(8); PG8_BAR; PG8_WAIT_L(0); PG8_MMA(0, 0, At, B0); PG8_BAR; PG8_SCHED;
            PG8_LDB(B1, 0, 1); PG8_STAGE(PG8_SB(0, 0), b2, voffB);
            PG8_BAR; PG8_WAIT_L(0); PG8_MMA(0, 1, At, B1); PG8_BAR;
            PG8_LDA(At, 0, 1); PG8_STAGE(PG8_SA(0, 0), a2, voffA);
            PG8_BAR; PG8_WAIT_L(0); PG8_MMA(1, 0, At, B0); PG8_BAR; PG8_SCHED;
            PG8_STAGE(PG8_SB(0, 1), b2 + hstep, voffB);
            PG8_WAIT_V(6); PG8_BAR; PG8_MMA(1, 1, At, B1); PG8_BAR;
            PG8_LDB(B0, 1, 0); PG8_SCHED; PG8_LDA(At, 1, 0); PG8_STAGE(PG8_SA(0, 1), a2 + hstep, voffA);
            PG8_WAIT_L(8); PG8_BAR; PG8_WAIT_L(0); PG8_MMA(0, 0, At, B0); PG8_BAR; PG8_SCHED;
            PG8_LDB(B1, 1, 1); PG8_STAGE(PG8_SB(1, 0), b3, voffB);
            PG8_BAR; PG8_WAIT_L(0); PG8_MMA(0, 1, At, B1); PG8_BAR;
            PG8_LDA(At, 1, 1); PG8_STAGE(PG8_SA(1, 0), a3, voffA);
            PG8_BAR; PG8_WAIT_L(0); PG8_MMA(1, 0, At, B0); PG8_BAR; PG8_SCHED;
            PG8_STAGE(PG8_SB(1, 1), b3 + hstep, voffB);
            PG8_WAIT_V(6); PG8_BAR; PG8_MMA(1, 1, At, B1); PG8_BAR;
        }
        E(acc, cur, wr, wc, fr, fq);
        if (!has_next) break;
#pragma unroll
        for (int a = 0; a < 2; ++a)
#pragma unroll
            for (int b = 0; b < 2; ++b)
#pragma unroll
                for (int m = 0; m < 4; ++m)
#pragma unroll
                    for (int n = 0; n < 2; ++n) acc[a][b][m][n] = (f32x4){0.f, 0.f, 0.f, 0.f};
        cur = nxt; cA = nA; cB = nB; ++ui; nt = cur.nt ? cur.nt : g.nt;
    }
    PG8_WAIT_V(0);
    if (wr == 0) PG8_BAR;
    PG8_BAR;
#undef PG8_SA
#undef PG8_SB
#undef PG8_STAGE
#undef PG8_LDA
#undef PG8_LDB
#undef PG8_MMA
#undef PG8_WAIT_V
#undef PG8_WAIT_L
#undef PG8_BAR
#undef PG8_SCHED
}
}

struct Epi1 {
    static constexpr bool PERM = true;
    P p; const LAS float* rsL;
    __device__ __forceinline__ void operator()(const f32x4 (&acc)[2][2][4][2], const pg8::Unit& u, int wr, int wc, int fr, int fq) const {
        unsigned char* ws = p.ws;
        const int row0 = u.pm * 256 + wr * 64 + fr, pn = u.pn;
        bf16_t* dst; int ld, cb; float sc = 1.f; float* fo = nullptr;
        if (pn < 2) { dst = (bf16_t*)(ws + O_GQ); ld = 512; cb = pn * 256; sc = 0.08838834764831845f; }
        else if (pn < 4) { dst = (bf16_t*)(ws + O_GK); ld = 512; cb = (pn - 2) * 256; }
        else if (pn < 8) { dst = (bf16_t*)(ws + O_GV); ld = 1024; cb = (pn - 4) * 256; }
        else if (pn < 12) { dst = (bf16_t*)(ws + O_GG); ld = 1024; cb = (pn - 8) * 256; }
        else if (pn < 16) { dst = (bf16_t*)(ws + O_AQ); ld = 1024; cb = (pn - 12) * 256; sc = 0.08838834764831845f * LOG2E; }
        else if (pn < 20) { dst = (bf16_t*)(ws + O_AK); ld = 1024; cb = (pn - 16) * 256; fo = p.out + OUT_KW; }
        else { dst = (bf16_t*)(ws + O_AV); ld = 1024; cb = (pn - 20) * 256; fo = p.out + OUT_VW; }
        float rsv[2][4];
#pragma unroll
        for (int ai = 0; ai < 2; ++ai)
#pragma unroll
            for (int m = 0; m < 4; ++m) rsv[ai][m] = rsL[u.ord * 256 + wr * 64 + fr + ai * 128 + m * 16];
        asm volatile("" ::: "memory");
#pragma unroll
        for (int ai = 0; ai < 2; ++ai)
#pragma unroll
            for (int m = 0; m < 4; ++m) {
                const int row = row0 + ai * 128 + m * 16; const float rs = rsv[ai][m] * sc;
                const int t = row & 4095;
#pragma unroll
                for (int bj = 0; bj < 2; ++bj) {
                    const int c = cb + bj * 128 + wc * 32 + 8 * fq;
                    const f32x4 v0 = acc[ai][bj][m][0] * rs, v1 = acc[ai][bj][m][1] * rs;
                    u32x4 w; w.x = cvt_pk_bf16(v0[0], v0[1]); w.y = cvt_pk_bf16(v0[2], v0[3]); w.z = cvt_pk_bf16(v1[0], v1[1]); w.w = cvt_pk_bf16(v1[2], v1[3]);
                    *(u32x4*)(dst + (size_t)row * ld + c) = w;
                    if (fo && t >= 2048) { float* o = fo + ((size_t)((row >> 12) * 2048 + t - 2048)) * 1024 + c; __builtin_nontemporal_store(v0, (f32x4*)o); __builtin_nontemporal_store(v1, (f32x4*)(o + 4)); }
                }
            }
    }
};

struct EpiO {
    static constexpr bool PERM = true;
    P p;
    __device__ __forceinline__ void operator()(const f32x4 (&acc)[2][2][4][2], const pg8::Unit& u, int wr, int wc, int fr, int fq) const {
        unsigned char* ws = p.ws;
        const bf16_t* XB = (const bf16_t*)(ws + O_XB); bf16_t* X1B = (bf16_t*)(ws + O_X1B); float* ss2 = (float*)(ws + O_SUMS);
        const int row0 = u.pm * 256 + wr * 64 + fr, col0 = u.pn * 256 + wc * 32 + 8 * fq;
        u32x4 xin[2][4][2];
#pragma unroll
        for (int ai = 0; ai < 2; ++ai)
#pragma unroll
            for (int m = 0; m < 4; ++m)
#pragma unroll
                for (int bj = 0; bj < 2; ++bj) xin[ai][m][bj] = __builtin_nontemporal_load((const u32x4*)(XB + (size_t)(row0 + ai * 128 + m * 16) * DM + col0 + bj * 128));
        asm volatile("" ::: "memory");
#pragma unroll
        for (int ai = 0; ai < 2; ++ai)
#pragma unroll
            for (int m = 0; m < 4; ++m) {
                const int row = row0 + ai * 128 + m * 16; float s = 0.f;
#pragma unroll
                for (int bj = 0; bj < 2; ++bj) {
                    const size_t off = (size_t)row * DM + col0 + bj * 128;
                    const u32x4 xr = xin[ai][m][bj];
                    f32x4 v0 = acc[ai][bj][m][0], v1 = acc[ai][bj][m][1];
                    v0[0] += bflo(xr.x); v0[1] += bfhi(xr.x); v0[2] += bflo(xr.y); v0[3] += bfhi(xr.y);
                    v1[0] += bflo(xr.z); v1[1] += bfhi(xr.z); v1[2] += bflo(xr.w); v1[3] += bfhi(xr.w);
                    u32x4 w; w.x = cvt_pk_bf16(v0[0], v0[1]); w.y = cvt_pk_bf16(v0[2], v0[3]); w.z = cvt_pk_bf16(v1[0], v1[1]); w.w = cvt_pk_bf16(v1[2], v1[3]);
                    *(u32x4*)(X1B + off) = w;
                    s += (v0[0] * v0[0] + v0[1] * v0[1]) + (v0[2] * v0[2] + v0[3] * v0[3]) + (v1[0] * v1[0] + v1[1] * v1[1]) + (v1[2] * v1[2] + v1[3] * v1[3]);
                }
                s += __shfl_xor(s, 16); s += __shfl_xor(s, 32);
                if (fq == 0) __hip_atomic_fetch_add(ss2 + row, s, __ATOMIC_RELAXED, __HIP_MEMORY_SCOPE_AGENT);
            }
    }
};

struct EpiU {
    static constexpr bool PERM = true;
    P p; const LAS float* rsL;
    __device__ __forceinline__ void operator()(const f32x4 (&acc)[2][2][4][2], const pg8::Unit& u, int wr, int wc, int fr, int fq) const {
        unsigned char* ws = p.ws;
        const float* ss2 = (const float*)(ws + O_SUMS); bf16_t* HM = (bf16_t*)(ws + O_HM);
        const int row0 = u.pm * 256 + wr * 64 + fr, col0 = u.pn * 256 + wc * 32 + 8 * fq;
        float rsv[2][4];
#pragma unroll
        for (int ai = 0; ai < 2; ++ai)
#pragma unroll
            for (int m = 0; m < 4; ++m) rsv[ai][m] = rsL[u.ord * 256 + wr * 64 + fr + ai * 128 + m * 16];
        asm volatile("" ::: "memory");
#pragma unroll
        for (int ai = 0; ai < 2; ++ai)
#pragma unroll
            for (int m = 0; m < 4; ++m) {
                const int row = row0 + ai * 128 + m * 16; const float rs = rsv[ai][m];
#pragma unroll
                for (int bj = 0; bj < 2; ++bj) {
                    f32x4 v0 = acc[ai][bj][m][0] * rs, v1 = acc[ai][bj][m][1] * rs;
#pragma unroll
                    for (int j = 0; j < 4; ++j) { v0[j] = fmaxf(v0[j], 0.f); v0[j] *= v0[j]; v1[j] = fmaxf(v1[j], 0.f); v1[j] *= v1[j]; }
                    u32x4 w; w.x = cvt_pk_bf16(v0[0], v0[1]); w.y = cvt_pk_bf16(v0[2], v0[3]); w.z = cvt_pk_bf16(v1[0], v1[1]); w.w = cvt_pk_bf16(v1[2], v1[3]);
                    *(u32x4*)(HM + (size_t)row * DFF + col0 + bj * 128) = w;
                }
            }
    }
};

struct EpiD {
    static constexpr bool PERM = true;
    P p;
    __device__ __forceinline__ void operator()(const f32x4 (&acc)[2][2][4][2], const pg8::Unit& u, int wr, int wc, int fr, int fq) const {
        const bf16_t* X1B = (const bf16_t*)(p.ws + O_X1B); bf16_t* X2B = (bf16_t*)(p.ws + O_CAT);
        const int row0 = u.pm * 256 + wr * 64 + fr, col0 = u.pn * 256 + wc * 32 + 8 * fq;
        u32x4 xin[2][4][2];
#pragma unroll
        for (int ai = 0; ai < 2; ++ai)
#pragma unroll
            for (int m = 0; m < 4; ++m)
#pragma unroll
                for (int bj = 0; bj < 2; ++bj) xin[ai][m][bj] = __builtin_nontemporal_load((const u32x4*)(X1B + (size_t)(row0 + ai * 128 + m * 16) * DM + col0 + bj * 128));
        asm volatile("" ::: "memory");
#pragma unroll
        for (int ai = 0; ai < 2; ++ai)
#pragma unroll
            for (int m = 0; m < 4; ++m) {
                const int row = row0 + ai * 128 + m * 16;
#pragma unroll
                for (int bj = 0; bj < 2; ++bj) {
                    const size_t off = (size_t)row * DM + col0 + bj * 128;
                    const u32x4 xr = xin[ai][m][bj];
                    f32x4 v0 = acc[ai][bj][m][0], v1 = acc[ai][bj][m][1];
                    v0[0] += bflo(xr.x); v0[1] += bfhi(xr.x); v0[2] += bflo(xr.y); v0[3] += bfhi(xr.y);
                    v1[0] += bflo(xr.z); v1[1] += bfhi(xr.z); v1[2] += bflo(xr.w); v1[3] += bfhi(xr.w);
                    u32x4 w; w.x = cvt_pk_bf16(v0[0], v0[1]); w.y = cvt_pk_bf16(v0[2], v0[3]); w.z = cvt_pk_bf16(v1[0], v1[1]); w.w = cvt_pk_bf16(v1[2], v1[3]);
                    *(u32x4*)(X2B + off) = w;
                }
            }
    }
};

struct EpiPart {
    static constexpr bool PERM = false;
    float* C; int ldc;
    __device__ __forceinline__ void operator()(const f32x4 (&acc)[2][2][4][2], const pg8::Unit& u, int wr, int wc, int fr, int fq) const {
        const int row0 = wr * 64 + fr, col0 = u.pn * 256 + wc * 32 + 4 * fq;
        float* base = C + (size_t)u.pm * TS * ldc;
#pragma unroll
        for (int m = 0; m < 4; ++m) {
            float* rp = base + (size_t)(row0 + m * 16) * ldc + col0;
#pragma unroll
            for (int bj = 0; bj < 2; ++bj)
#pragma unroll
                for (int n = 0; n < 2; ++n) *(f32x4*)(rp + bj * 128 + n * 16) = acc[0][bj][m][n];
        }
    }
};

struct EpiPartP {
    float* C; int ldc;
    __device__ __forceinline__ void operator()(const f32x4 (&acc)[2][2][4][2], const pg8::Unit& u, int wr, int wc, int fr, int fq) const {
        const int row0 = wr * 64 + fr, col0 = u.pn * 256 + wc * 32 + 8 * fq;
        float* base = C + (size_t)u.pm * TS * ldc;
#pragma unroll
        for (int m = 0; m < 4; ++m) {
            float* rp = base + (size_t)(row0 + m * 16) * ldc + col0;
#pragma unroll
            for (int bj = 0; bj < 2; ++bj) { *(f32x4*)(rp + bj * 128) = acc[0][bj][m][0]; *(f32x4*)(rp + bj * 128 + 4) = acc[0][bj][m][1]; }
        }
    }
};
template <class Main> struct EpiBoth {
    static constexpr bool PERM = true, AFTER_DRAIN = false;
    Main m; EpiPartP q;
    __device__ __forceinline__ void operator()(const f32x4 (&acc)[2][2][4][2], const pg8::Unit& u, int wr, int wc, int fr, int fq) const {
        if (u.kind == 0) m(acc, u, wr, wc, fr, fq); else q(acc, u, wr, wc, fr, fq);
    }
};

template <int NB>
__device__ __forceinline__ void skinny(const bf16_t* A, int lda, const bf16_t* Bt, int ldb, int klen, f32x4 (&acc)[NB], int lane) {
    const int fr = lane & 15, fq = lane >> 4;
    const bf16x8* ap = (const bf16x8*)(A + (size_t)fr * lda + fq * 8);
    const bf16x8* bp[NB];
#pragma unroll
    for (int nb = 0; nb < NB; ++nb) { bp[nb] = (const bf16x8*)(Bt + (size_t)(nb * 16 + fr) * ldb + fq * 8); acc[nb] = (f32x4){0.f, 0.f, 0.f, 0.f}; }
    const int nks = klen / 32;
#pragma unroll 8
    for (int ks = 0; ks < nks; ++ks) {
        const bf16x8 a = ap[ks * 4];
#pragma unroll
        for (int nb = 0; nb < NB; ++nb) { const bf16x8 b = bp[nb][ks * 4]; acc[nb] = mfma16(b, a, acc[nb]); }
    }
}

__device__ __forceinline__ void tr_item(const float* W, int ldw, int k0, int n0, int nvalid, const float* nw, bf16_t* WT, int K, int drow0, LAS float* scr, int lane) {
    float tv[64];
    { const float* wp = W + (size_t)k0 * ldw + n0 + (lane < nvalid ? lane : 0);
#pragma unroll
      for (int i = 0; i < 64; ++i) tv[i] = __builtin_nontemporal_load(wp + (size_t)i * ldw);
#pragma unroll
      for (int i = 0; i < 64; ++i) { float v = tv[i]; if (nw) v *= nw[k0 + i]; scr[i * 65 + lane] = v; } }
    asm volatile("s_waitcnt lgkmcnt(0)" ::: "memory");
    const int c = lane & 7;
#pragma unroll
    for (int j = 0; j < 8; ++j) { const int n = (lane >> 3) + 8 * j; const LAS float* s = scr + (8 * c) * 65 + n;
        u32x4 o; o.x = cvt_pk_bf16(s[0 * 65], s[1 * 65]); o.y = cvt_pk_bf16(s[2 * 65], s[3 * 65]); o.z = cvt_pk_bf16(s[4 * 65], s[5 * 65]); o.w = cvt_pk_bf16(s[6 * 65], s[7 * 65]);
        if (n < nvalid) *(u32x4*)(WT + (size_t)(drow0 + n) * K + k0 + 8 * c) = o; }
    asm volatile("s_waitcnt lgkmcnt(0)" ::: "memory");
}

__device__ __forceinline__ void phase0(const P& p, LAS unsigned char* lds, int tid, int G) {
    unsigned char* ws = p.ws;
    const int wave = tid >> 6, lane = tid & 63;
    const int gw = blockIdx.x * 8 + wave, NGW = G * 8;
    float* sums = (float*)(ws + O_SUMS);
    for (int i = blockIdx.x * NTHR + tid; i < MT; i += G * NTHR) sums[i] = 0.f;
    float* rstd1 = (float*)(ws + O_RSTD1); bf16_t* XB = (bf16_t*)(ws + O_XB);
    for (int mb = gw; mb < MT; mb += 2 * NGW) {
        f32x4 v[2][8];
#pragma unroll
        for (int q = 0; q < 2; ++q) { const int m = mb + q * NGW;
            if (m < MT) { const float* xr = m < TP ? p.x_prompt + (size_t)m * DM : p.x_sample + (size_t)(m - TP) * DM;
#pragma unroll
                for (int j = 0; j < 8; ++j) v[q][j] = __builtin_nontemporal_load((const f32x4*)xr + lane + 64 * j); } }
        asm volatile("" ::: "memory");
#pragma unroll
        for (int q = 0; q < 2; ++q) { const int m = mb + q * NGW;
            if (m < MT) { float s = 0.f;
#pragma unroll
                for (int j = 0; j < 8; ++j) s += (v[q][j][0] * v[q][j][0] + v[q][j][1] * v[q][j][1]) + (v[q][j][2] * v[q][j][2] + v[q][j][3] * v[q][j][3]);
                s = wave_sum(s);
                if (lane == 0) rstd1[m] = rsqrtf(s * (1.f / DM) + EPS);
                u32x2* o = (u32x2*)(XB + (size_t)m * DM);
#pragma unroll
                for (int j = 0; j < 8; ++j) { u32x2 w; w.x = cvt_pk_bf16(v[q][j][0], v[q][j][1]); w.y = cvt_pk_bf16(v[q][j][2], v[q][j][3]); o[lane + 64 * j] = w; } } }
    }
    LAS float* scr = (LAS float*)(lds + wave * 16640);
    bf16_t* BT1 = (bf16_t*)(ws + O_BT1); bf16_t* BTG = (bf16_t*)(ws + O_BTG);
    constexpr int I_IN = 32 * 96, I_G = 32;
    constexpr int NIT = I_IN + I_G;
    for (int it = gw; it < NIT; it += NGW) {
        int r = it;
        if (r < I_IN) { const int kb = r / 96, nb = r % 96; const int src_n0 = nb < 48 ? nb * 64 : 3088 + (nb - 48) * 64;
            tr_item(p.w_in, 6160, kb * 64, src_n0, 64, p.attn_norm_w, BT1, DM, nb * 64, scr, lane); continue; }
        r -= I_IN;
        tr_item(p.w_in, 6160, r * 64, 3072, 16, p.attn_norm_w, BTG, DM, 0, scr, lane);
    }
}
__device__ __forceinline__ void side_transposes(const P& p, LAS unsigned char* lds, int sw, int lane, int G) {
    unsigned char* ws = p.ws;
    LAS float* scr = (LAS float*)(lds + sw * 16640);
    bf16_t* BTO = (bf16_t*)(ws + O_BTO); bf16_t* BTU = (bf16_t*)(ws + O_BTU); bf16_t* BTD = (bf16_t*)(ws + O_BTD);
    constexpr int I_O = 32 * 32, I_U = 32 * 128, I_D = 128 * 32;
    for (int it = sw * G + blockIdx.x; it < I_O + I_U + I_D; it += 4 * G) {
        int r = it;
        if (r < I_O) { const int kb = r / 32, nb = r % 32; tr_item(p.w_out, DM, kb * 64, nb * 64, 64, nullptr, BTO, DM, nb * 64, scr, lane); continue; }
        r -= I_O;
        if (r < I_U) { const int kb = r / 128, nb = r % 128; tr_item(p.w_up, DFF, kb * 64, nb * 64, 64, p.ffn_norm_w, BTU, DM, nb * 64, scr, lane); continue; }
        r -= I_U;
        { const int kb = r / 32, nb = r % 32; tr_item(p.w_down, DM, kb * 64, nb * 64, 64, nullptr, BTD, DFF, nb * 64, scr, lane); }
    }
}

__device__ __forceinline__ void phase1_skinny(const P& p, LAS unsigned char* lds, int tid, int G) {
    unsigned char* ws = p.ws;
    const int wave = tid >> 6, lane = tid & 63, fr = lane & 15, fq = lane >> 4;
    const bf16_t* XB = (const bf16_t*)(ws + O_XB); const float* rstd1 = (const float*)(ws + O_RSTD1);
    float* GLR = (float*)(ws + O_GLR);
    const int rg = wave >> 2, kq = wave & 3;
    for (int k = 0; k * G < MT / 32; ++k) {
        const int it = k * G + ((k & 1) ? (G - 1 - (int)blockIdx.x) : (int)blockIdx.x);
        if (it >= MT / 32) break;
        f32x4 acc[1];
        skinny<1>(XB + (size_t)(it * 32 + rg * 16) * DM + kq * 512, DM, (const bf16_t*)(ws + O_BTG) + kq * 512, DM, 512, acc, lane);
        __syncthreads();
        *(LAS f32x4*)(lds + (wave * 64 + lane) * 16) = acc[0];
        __syncthreads();
        if (kq == 0) {
            f32x4 v = acc[0];
#pragma unroll
            for (int q = 1; q < 4; ++q) v += *(const LAS f32x4*)(lds + ((wave + q) * 64 + lane) * 16);
            const int row = it * 32 + rg * 16 + fr;
            *(f32x4*)(GLR + (size_t)row * 16 + 4 * fq) = v * rstd1[row];
        }
    }
}

__device__ __forceinline__ void attn_issue(const P& p, int it, int tid, u32x4 (&kv)[8], u32x4 (&vv)[8], bf16x8 (&qf)[4]) {
    unsigned char* ws = p.ws;
    const int wid = tid >> 6, lane = tid & 63, fr = lane & 15, fq = lane >> 4;
    const int g = it >> 9, rem = it & 511, b = rem >> 8, h = (rem >> 5) & 7, sub = rem & 31;
    const int dsh = 2 * g, d = 1 << dsh, nbs = 5 - dsh;
    const int r = sub >> nbs, n = sub & ((1 << nbs) - 1);
    const bf16_t* AKp = (const bf16_t*)(ws + O_AK) + (size_t)b * SEQ * 1024 + h * 128;
    const bf16_t* AVp = (const bf16_t*)(ws + O_AV) + (size_t)b * SEQ * 1024 + h * 128;
#pragma unroll
    for (int ps = 0; ps < 8; ++ps) {
        const int row = (tid >> 4) + 32 * ps, ch = tid & 15, lk = 128 * (n - 1) + row;
        kv[ps] = (u32x4){0u, 0u, 0u, 0u}; vv[ps] = (u32x4){0u, 0u, 0u, 0u};
        if (lk >= 0) { const size_t t = (size_t)lk * d + r; kv[ps] = *(const u32x4*)(AKp + t * 1024 + ch * 8); vv[ps] = *(const u32x4*)(AVp + t * 1024 + ch * 8); }
    }
    const int tq = (128 * n + 16 * wid + fr) * d + r;
    const bf16_t* qp = (const bf16_t*)(ws + O_AQ) + ((size_t)b * SEQ + tq) * 1024 + h * 128 + fq * 8;
#pragma unroll
    for (int ks = 0; ks < 4; ++ks) qf[ks] = *(const bf16x8*)(qp + 32 * ks);
}

__device__ __forceinline__ void attn_prompt_loop(const P& p, LAS unsigned char* lds, int tid, int G) {
    unsigned char* ws = p.ws;
    const int wid = tid >> 6, lane = tid & 63, fr = lane & 15, fq = lane >> 4;
    u32x4 kvr[8], vvr[8]; bf16x8 qn[4];
    int it = blockIdx.x;
    if (it < 1536) attn_issue(p, it, tid, kvr, vvr, qn);
    for (; it < 1536; it += G) {
    const int g = it >> 9, rem = it & 511, b = rem >> 8, h = (rem >> 5) & 7, sub = rem & 31;
    const int dsh = 2 * g, d = 1 << dsh, nbs = 5 - dsh;
    const int r = sub >> nbs, n = sub & ((1 << nbs) - 1);
    __syncthreads();
#pragma unroll
    for (int ps = 0; ps < 8; ++ps) {
        const int row = (tid >> 4) + 32 * ps, ch = tid & 15;
        *(LAS u32x4*)(lds + offb(row, ch)) = kvr[ps]; *(LAS u32x4*)(lds + 65536 + offb(row, ch)) = vvr[ps];
    }
    const int tq = (128 * n + 16 * wid + fr) * d + r;
    __syncthreads();
    const int kb0 = 2 * (wid >> 1);
    f32x4 sacc[10];
#pragma unroll
    for (int kbi = 0; kbi < 10; ++kbi) {
        sacc[kbi] = (f32x4){0.f, 0.f, 0.f, 0.f};
        const unsigned key = 16 * (kb0 + kbi) + fr;
#pragma unroll
        for (int ks = 0; ks < 4; ++ks) { const bf16x8 kf = *(const LAS bf16x8*)(lds + offb(key, 4 * ks + fq)); sacc[kbi] = mfma16(kf, qn[ks], sacc[kbi]); }
    }
    int rel = 16 * (wid & 1) + fr - 4 * fq; asm volatile("" : "+v"(rel));
    const float slope2 = fexp2(-(float)(h + 1)) * LOG2E * (float)d;
    const float c0 = -slope2 * (float)(rel + 128);
    float mx = -INFINITY;
#pragma unroll
    for (int kbi = 0; kbi < 10; ++kbi) {
        const bool blk_ok = (n > 0) || (kb0 + kbi >= 8);
#pragma unroll
        for (int j = 0; j < 4; ++j) {
            bool valid = blk_ok;
            if (kbi <= 1) valid = valid && (rel - 16 * kbi - j <= 0);
            if (kbi >= 8) valid = valid && (rel + 128 - 16 * kbi - j >= 0);
            const float s = valid ? sacc[kbi][j] + (c0 + slope2 * (float)(16 * kbi + j)) : -INFINITY;
            sacc[kbi][j] = s; mx = fmaxf(mx, s);
        }
    }
    mx = fmaxf(mx, __shfl_xor(mx, 16)); mx = fmaxf(mx, __shfl_xor(mx, 32));
    float l = 0.f;
#pragma unroll
    for (int kbi = 0; kbi < 10; ++kbi)
#pragma unroll
        for (int j = 0; j < 4; ++j) { const float pe = fexp2(sacc[kbi][j] - mx); sacc[kbi][j] = pe; l += pe; }
    l += __shfl_xor(l, 16); l += __shfl_xor(l, 32);
    if (it + G < 1536) attn_issue(p, it + G, tid, kvr, vvr, qn);
    f32x4 oacc[8];
#pragma unroll
    for (int eb = 0; eb < 8; ++eb) oacc[eb] = (f32x4){0.f, 0.f, 0.f, 0.f};
    const unsigned vbase = (unsigned)(size_t)(lds + 65536);
    const unsigned q_ = (lane & 15) >> 2, pp = lane & 3;
    const unsigned a00 = vbase + offb(16 * kb0 + 4 * fq + q_, (pp >> 1)) + 8 * (pp & 1);
#pragma unroll
    for (int ks = 0; ks < 5; ++ks) {
        const bf16x8 pf = pack8(sacc[2 * ks], sacc[2 * ks + 1]);
#pragma unroll
        for (int e4 = 0; e4 < 2; ++e4) {
            unsigned av[4]; bf16x8 vf[4];
#pragma unroll
            for (int eb = 0; eb < 4; ++eb) av[eb] = (a00 + (unsigned)(ks * 8192)) ^ (unsigned)((e4 * 4 + eb) << 5);
            tr_read_4x2(av, vf);
#pragma unroll
            for (int eb = 0; eb < 4; ++eb) oacc[e4 * 4 + eb] = mfma16(vf[eb], pf, oacc[e4 * 4 + eb]);
        }
    }
    const float inv = 1.f / l;
    bf16_t* op = (bf16_t*)(ws + O_OATT) + ((size_t)g * TP + (size_t)b * SEQ + tq) * 1024 + h * 128 + 4 * fq;
#pragma unroll
    for (int eb = 0; eb < 8; ++eb) { const f32x4 o = oacc[eb] * inv; u32x2 w; w.x = cvt_pk_bf16(o[0], o[1]); w.y = cvt_pk_bf16(o[2], o[3]); *(u32x2*)(op + 16 * eb) = w; }
    if (fq == 0) ((float*)(ws + O_LSE))[((size_t)g * TP + (size_t)b * SEQ + tq) * 8 + h] = mx + flog2(l);
    }
}

__device__ __forceinline__ void attn_sample_item(const P& p, int wi, int lane) {
    unsigned char* ws = p.ws;
    const int bs = wi >> 5, i = (wi >> 3) & 3, h = wi & 7;
    const int kg = lane >> 4, li = lane & 15;
    const int srow = bs * 4 + i;
    const float* ACC1 = (const float*)(ws + O_ACC1); const float* rstd1 = (const float*)(ws + O_RSTD1);
    float q[8];
    { const float rq = rstd1[TP + srow] * (0.08838834764831845f * LOG2E);
      const f32x4 q0 = acc1_4(ACC1, srow, 3072 + h * 128 + 8 * li), q1 = acc1_4(ACC1, srow, 3072 + h * 128 + 8 * li + 4);
      q[0] = q0[0] * rq; q[1] = q0[1] * rq; q[2] = q0[2] * rq; q[3] = q0[3] * rq; q[4] = q1[0] * rq; q[5] = q1[1] * rq; q[6] = q1[2] * rq; q[7] = q1[3] * rq; }
    if (kg == 0) {
        const float rs = rstd1[TP + srow];
        float* ko = p.out + OUT_KN + (size_t)srow * 1024 + h * 128 + 8 * li; float* vo = p.out + OUT_VN + (size_t)srow * 1024 + h * 128 + 8 * li;
        *(f32x4*)ko = acc1_4(ACC1, srow, 4096 + h * 128 + 8 * li) * rs; *(f32x4*)(ko + 4) = acc1_4(ACC1, srow, 4096 + h * 128 + 8 * li + 4) * rs;
        *(f32x4*)vo = acc1_4(ACC1, srow, 5120 + h * 128 + 8 * li) * rs; *(f32x4*)(vo + 4) = acc1_4(ACC1, srow, 5120 + h * 128 + 8 * li + 4) * rs;
    }
    float m = -1e30f, l = 0.f, acc[8];
#pragma unroll
    for (int e = 0; e < 8; ++e) acc[e] = 0.f;
    const float sl = fexp2(-(float)(h + 1)) * LOG2E;
    for (int g = 0; g < 3; ++g) {
        const int d = 1 << (2 * g);
#pragma unroll 3
        for (int jj = 0; jj < 33; ++jj) {
            const int j = 4 * jj + kg; const bool valid = j <= 128; const int jc = valid ? j : 128;
            const int idx = 2048 + i - d * jc;
            f32x4 k0, k1, v0, v1;
            if (idx < 2048) { const size_t off = (((size_t)bs * 2048 + idx) * 8 + h) * 128 + 8 * li;
                k0 = __builtin_nontemporal_load((const f32x4*)(p.cache_k + off)); k1 = __builtin_nontemporal_load((const f32x4*)(p.cache_k + off + 4)); v0 = __builtin_nontemporal_load((const f32x4*)(p.cache_v + off)); v1 = __builtin_nontemporal_load((const f32x4*)(p.cache_v + off + 4)); }
            else { const int nr = bs * 4 + (idx - 2048); const float rsn = rstd1[TP + nr]; const int c0 = 4096 + h * 128 + 8 * li;
                k0 = acc1_4(ACC1, nr, c0) * rsn; k1 = acc1_4(ACC1, nr, c0 + 4) * rsn; v0 = acc1_4(ACC1, nr, c0 + 1024) * rsn; v1 = acc1_4(ACC1, nr, c0 + 1028) * rsn; }
            float dot = (q[0] * k0[0] + q[1] * k0[1]) + (q[2] * k0[2] + q[3] * k0[3]) + (q[4] * k1[0] + q[5] * k1[1]) + (q[6] * k1[2] + q[7] * k1[3]);
            dot += __shfl_xor(dot, 1); dot += __shfl_xor(dot, 2); dot += __shfl_xor(dot, 4); dot += __shfl_xor(dot, 8);
            const float s = valid ? dot - sl * (float)(d * j) : -INFINITY;
            const float mn = fmaxf(m, s), sc = fexp2(m - mn), pe = fexp2(s - mn);
            l = l * sc + pe;
            acc[0] = acc[0] * sc + pe * v0[0]; acc[1] = acc[1] * sc + pe * v0[1]; acc[2] = acc[2] * sc + pe * v0[2]; acc[3] = acc[3] * sc + pe * v0[3];
            acc[4] = acc[4] * sc + pe * v1[0]; acc[5] = acc[5] * sc + pe * v1[1]; acc[6] = acc[6] * sc + pe * v1[2]; acc[7] = acc[7] * sc + pe * v1[3];
            m = mn;
        }
    }
    float mt = fmaxf(m, __shfl_xor(m, 16)); mt = fmaxf(mt, __shfl_xor(mt, 32));
    const float f = fexp2(m - mt);
    l *= f; l += __shfl_xor(l, 16); l += __shfl_xor(l, 32);
    const float inv = 1.f / l;
    float* o = (float*)(ws + O_ATTS) + (size_t)srow * 1024 + h * 128 + 8 * li;
#pragma unroll
    for (int e = 0; e < 8; ++e) { float a = acc[e] * f; a += __shfl_xor(a, 16); a += __shfl_xor(a, 32); acc[e] = a * inv; }
    if (kg == 0) { *(f32x4*)o = (f32x4){acc[0], acc[1], acc[2], acc[3]}; *(f32x4*)(o + 4) = (f32x4){acc[4], acc[5], acc[6], acc[7]}; }
}

__device__ __forceinline__ float logsig(float x) { return fminf(x, 0.f) - __logf(1.f + __expf(-fabsf(x))); }

__device__ __forceinline__ void gla_a_item(const P& p, LAS unsigned char* lds, int it, int tid) {
    unsigned char* ws = p.ws;
    const int wid = tid >> 6, lane = tid & 63, fr = lane & 15, fq = lane >> 4;
    const int bh = it >> 6, c = it & 63, b = bh >> 2, h = bh & 3;
    const int row0 = b * SEQ + 64 * c;
    LAS float* sGLR = (LAS float*)lds;
    LAS float* sTot = (LAS float*)(lds + 4096);
    LAS unsigned char* sKt = lds + 8192;
    LAS unsigned char* sV = lds + 8192 + 16384;
    __syncthreads();
    if (tid < 256) *(LAS f32x4*)(sGLR + 4 * tid) = *(const f32x4*)((const float*)(ws + O_GLR) + (size_t)row0 * 16 + 4 * tid);
    const bf16_t* GV = (const bf16_t*)(ws + O_GV);
#pragma unroll
    for (int i = 0; i < 4; ++i) { const int q = tid + 512 * i, row = q >> 5, ch32 = q & 31;
        const u32x4 v = *(const u32x4*)(GV + (size_t)(row0 + row) * 1024 + h * 256 + ch32 * 8);
        *(LAS u32x4*)(sV + (ch32 >> 4) * 16384 + offb(row, ch32 & 15)) = v; }
    const int k = tid & 127, tg = tid >> 7;
    float w[16];
#pragma unroll
    for (int r = 0; r < 16; ++r) w[r] = p.w_gk_up[r * 512 + h * 128 + k];
    const float bias = p.b_gk[h * 128 + k];
    float kvals[16];
    { const bf16_t* GKp = (const bf16_t*)(ws + O_GK) + (size_t)(row0 + tg * 16) * 512 + h * 128 + k;
#pragma unroll
      for (int tt = 0; tt < 16; ++tt) kvals[tt] = bf2f(GKp[(size_t)tt * 512]); }
    __syncthreads();
    float cs[16]; float run = 0.f;
#pragma unroll
    for (int tt = 0; tt < 16; ++tt) { const int t = tg * 16 + tt; float x = bias;
#pragma unroll
        for (int r = 0; r < 16; ++r) x += sGLR[t * 16 + r] * w[r];
        run += logsig(x) * (1.f / 16.f); cs[tt] = run; }
    sTot[tg * 128 + k] = run;
    __syncthreads();
    float off = 0.f, tot = 0.f;
#pragma unroll
    for (int gi = 0; gi < 4; ++gi) { const float v = sTot[gi * 128 + k]; if (gi < tg) off += v; tot += v; }
    float* BCUM = (float*)(ws + O_BCUM);
#pragma unroll
    for (int tt = 0; tt < 16; ++tt) { const int t = tg * 16 + tt; const float bt = off + cs[tt];
        BCUM[(size_t)(row0 + t) * 512 + h * 128 + k] = bt;
        const float kval = kvals[tt];
        *(LAS bf16_t*)(sKt + offb(t, k >> 3) + 2 * (k & 7)) = f2bf(kval * __expf(tot - bt)); }
    if (tg == 0) ((float*)(ws + O_DEC))[(size_t)it * 128 + k] = __expf(tot);
    __syncthreads();
    const unsigned q_ = (lane & 15) >> 2, pp = lane & 3;
    const unsigned kbase = (unsigned)(size_t)sKt, vb0 = (unsigned)(size_t)sV;
    bf16x8 kf[2];
#pragma unroll
    for (int ks = 0; ks < 2; ++ks) { const unsigned R0 = 32 * ks + 8 * fq + q_;
        kf[ks] = tr_read2(kbase + offb(R0, 2 * wid + (pp >> 1)) + 8 * (pp & 1), kbase + offb(R0 + 4, 2 * wid + (pp >> 1)) + 8 * (pp & 1)); }
    float* DS = (float*)(ws + O_DS) + ((size_t)it * 128 + 16 * wid + fr) * 256 + 4 * fq;
#pragma unroll 4
    for (int vb = 0; vb < 16; ++vb) {
        const unsigned vbase = vb0 + (vb >> 3) * 16384; const int cb = vb & 7;
        f32x4 a = (f32x4){0.f, 0.f, 0.f, 0.f};
        { const unsigned R0 = 8 * fq + q_; bf16x8 v0, v1;
          tr_read2x2(vbase + offb(R0, 2 * cb + (pp >> 1)) + 8 * (pp & 1), vbase + offb(R0 + 4, 2 * cb + (pp >> 1)) + 8 * (pp & 1),
                     vbase + offb(R0 + 32, 2 * cb + (pp >> 1)) + 8 * (pp & 1), vbase + offb(R0 + 36, 2 * cb + (pp >> 1)) + 8 * (pp & 1), v0, v1);
          a = mfma16(v0, kf[0], a); a = mfma16(v1, kf[1], a); }
        *(f32x4*)(DS + 16 * vb) = a;
    }
}

__device__ __forceinline__ void gla_sample_item(const P& p, LAS unsigned char* lds, int it, int tid) {
    unsigned char* ws = p.ws;
    const int bs = it >> 3, h = (it >> 1) & 3, vh = it & 1;
    LAS float* sA = (LAS float*)lds;
    LAS float* sK = sA + 512;
    LAS float* sQ = sK + 512;
    LAS float* sRed = sQ + 512;
    const float* ACC1 = (const float*)(ws + O_ACC1); const float* rstd1 = (const float*)(ws + O_RSTD1);
    __syncthreads();
    { const int i = tid >> 7, k = tid & 127; const int row = TP + bs * 4 + i;
      const float* glr = (const float*)(ws + O_GLR) + (size_t)row * 16;
      float x = p.b_gk[h * 128 + k];
#pragma unroll
      for (int r = 0; r < 16; ++r) x += glr[r] * p.w_gk_up[r * 512 + h * 128 + k];
      sA[tid] = __expf(logsig(x) * (1.f / 16.f));
      const float rs = rstd1[row];
      sK[tid] = acc1_1(ACC1, bs * 4 + i, 512 + h * 128 + k) * rs;
      sQ[tid] = acc1_1(ACC1, bs * 4 + i, h * 128 + k) * rs * 0.08838834764831845f; }
    const int kq = tid >> 5, vc4 = tid & 31, v = vh * 128 + 4 * vc4;
    const float* s0 = p.state_gla + (((size_t)bs * 4 + h) * 128 + kq * 8) * 256 + v;
    f32x4 S[8];
#pragma unroll
    for (int kk = 0; kk < 8; ++kk) S[kk] = __builtin_nontemporal_load((const f32x4*)(s0 + (size_t)kk * 256));
    f32x4 vv[4];
#pragma unroll
    for (int i = 0; i < 4; ++i) vv[i] = acc1_4(ACC1, bs * 4 + i, 1024 + h * 256 + v) * rstd1[TP + bs * 4 + i];
    __syncthreads();
    float* GLAOS = (float*)(ws + O_GLAOS);
    LAS float* sRed4 = sRed;
#pragma unroll
    for (int i = 0; i < 4; ++i) {
        f32x4 po = (f32x4){0.f, 0.f, 0.f, 0.f};
#pragma unroll
        for (int kk = 0; kk < 8; ++kk) { const int k = kq * 8 + kk; S[kk] = S[kk] * sA[i * 128 + k] + vv[i] * sK[i * 128 + k]; po += S[kk] * sQ[i * 128 + k]; }
        *(LAS f32x4*)(sRed4 + (i * 16 + kq) * 128 + 4 * vc4) = po;
    }
    __syncthreads();
    { const int i = tid >> 7, vcol = tid & 127; float o = 0.f;
#pragma unroll
      for (int g2 = 0; g2 < 16; ++g2) o += sRed4[(i * 16 + g2) * 128 + vcol];
      GLAOS[(size_t)(bs * 4 + i) * 1024 + h * 256 + vh * 128 + vcol] = o; }
    float* so = p.out + OUT_GS + (((size_t)bs * 4 + h) * 128 + kq * 8) * 256 + v;
#pragma unroll
    for (int kk = 0; kk < 8; ++kk) __builtin_nontemporal_store(S[kk], (f32x4*)(so + (size_t)kk * 256));
}

__device__ __forceinline__ void phase3(const P& p, int tid, int G) {
    unsigned char* ws = p.ws;
    const int wave = tid >> 6, lane = tid & 63;
    bf16_t* CAT = (bf16_t*)(ws + O_CAT);
    {
        const float* DS = (const float*)(ws + O_DS); const float* DEC = (const float*)(ws + O_DEC); bf16_t* SC = (bf16_t*)(ws + O_SC);
        const bf16_t* OATT = (const bf16_t*)(ws + O_OATT); const float* LSE = (const float*)(ws + O_LSE);
        const int nscan = 8 * 128 * 128, stride_t = G * NTHR, stride_w = G * 8;
        int e2 = blockIdx.x * NTHR + tid, row = blockIdx.x * 8 + wave;
        while (e2 < nscan || row < TP) {
            const bool do_scan = e2 < nscan;
            const int bh = e2 >> 14, k = (e2 >> 7) & 127, v = (e2 & 127) * 2;
            f32x2 S = (f32x2){0.f, 0.f};
            for (int seg = 0; seg < 4; ++seg) {
                const bool do_row = row < TP;
                const int h = lane >> 3;
                float l0 = 0.f, l1 = 0.f, l2 = 0.f; u32x4 r[3][2];
                if (do_row) {
                    l0 = LSE[((size_t)0 * TP + row) * 8 + h]; l1 = LSE[((size_t)1 * TP + row) * 8 + h]; l2 = LSE[((size_t)2 * TP + row) * 8 + h];
#pragma unroll
                    for (int g = 0; g < 3; ++g) { const u32x4* src = (const u32x4*)(OATT + ((size_t)g * TP + row) * 1024 + 16 * lane);
                        r[g][0] = __builtin_nontemporal_load(src); r[g][1] = __builtin_nontemporal_load(src + 1); }
                }
                if (do_scan) {
#pragma unroll 8
                    for (int cc = 0; cc < 16; ++cc) {
                        const size_t it = (size_t)bh * 64 + seg * 16 + cc; const size_t o = (it * 128 + k) * 256 + v;
                        *(unsigned*)(SC + o) = cvt_pk_bf16(S[0], S[1]);
                        const float dec = DEC[it * 128 + k]; const f32x2 ds = __builtin_nontemporal_load((const f32x2*)(DS + o));
                        S = S * dec + ds;
                    }
                }
                if (do_row) {
                    const float mx = fmaxf(l0, fmaxf(l1, l2));
                    float w0 = fexp2(l0 - mx), w1 = fexp2(l1 - mx), w2 = fexp2(l2 - mx); const float inv = 1.f / (w0 + w1 + w2); w0 *= inv; w1 *= inv; w2 *= inv;
                    float o[16];
#pragma unroll
                    for (int e = 0; e < 16; ++e) o[e] = 0.f;
#pragma unroll
                    for (int g = 0; g < 3; ++g) { const float wg = g == 0 ? w0 : (g == 1 ? w1 : w2);
#pragma unroll
                        for (int hh = 0; hh < 2; ++hh) { const u32x4 q = r[g][hh];
                            o[8 * hh + 0] += wg * bflo(q.x); o[8 * hh + 1] += wg * bfhi(q.x); o[8 * hh + 2] += wg * bflo(q.y); o[8 * hh + 3] += wg * bfhi(q.y);
                            o[8 * hh + 4] += wg * bflo(q.z); o[8 * hh + 5] += wg * bfhi(q.z); o[8 * hh + 6] += wg * bflo(q.w); o[8 * hh + 7] += wg * bfhi(q.w); } }
                    float ss = 0.f;
#pragma unroll
                    for (int e = 0; e < 16; ++e) ss += o[e] * o[e];
                    ss = wave_sum(ss);
                    const float rs = rsqrtf(ss * (1.f / 1024.f) + EPS);
                    const f32x4* nw = (const f32x4*)(p.att_out_norm_w + 16 * lane);
                    u32x4* dst = (u32x4*)(CAT + (size_t)row * DM + 1024 + 16 * lane);
#pragma unroll
                    for (int hh = 0; hh < 2; ++hh) { const f32x4 n0 = nw[2 * hh], n1 = nw[2 * hh + 1]; u32x4 w;
                        w.x = cvt_pk_bf16(o[8 * hh + 0] * rs * n0[0], o[8 * hh + 1] * rs * n0[1]); w.y = cvt_pk_bf16(o[8 * hh + 2] * rs * n0[2], o[8 * hh + 3] * rs * n0[3]);
                        w.z = cvt_pk_bf16(o[8 * hh + 4] * rs * n1[0], o[8 * hh + 5] * rs * n1[1]); w.w = cvt_pk_bf16(o[8 * hh + 6] * rs * n1[2], o[8 * hh + 7] * rs * n1[3]);
                        dst[hh] = w; }
                    row += stride_w;
                }
            }
            if (do_scan) { *(f32x2*)(p.out + OUT_GP + ((size_t)bh * 128 + k) * 256 + v) = S; e2 += stride_t; }
        }
    }
    {
        const float* GLAOS = (const float*)(ws + O_GLAOS); const float* ATTS = (const float*)(ws + O_ATTS); const float* ACC1 = (const float*)(ws + O_ACC1);
        for (int s = blockIdx.x * 8 + wave; s < TS; s += G * 8) {
            const int row = TP + s; const float rs1 = ((const float*)(ws + O_RSTD1))[row];
            float o[16], a[16];
#pragma unroll
            for (int q4 = 0; q4 < 4; ++q4) { const f32x4 t = *(const f32x4*)(GLAOS + (size_t)s * 1024 + 16 * lane + 4 * q4), u = *(const f32x4*)(ATTS + (size_t)s * 1024 + 16 * lane + 4 * q4);
                o[4 * q4] = t[0]; o[4 * q4 + 1] = t[1]; o[4 * q4 + 2] = t[2]; o[4 * q4 + 3] = t[3]; a[4 * q4] = u[0]; a[4 * q4 + 1] = u[1]; a[4 * q4 + 2] = u[2]; a[4 * q4 + 3] = u[3]; }
            float sg = 0.f, sa = 0.f;
#pragma unroll
            for (int e = 0; e < 16; ++e) { sg += o[e] * o[e]; sa += a[e] * a[e]; }
            sg += __shfl_xor(sg, 1); sg += __shfl_xor(sg, 2); sg += __shfl_xor(sg, 4); sg += __shfl_xor(sg, 8);
            sa = wave_sum(sa);
            const float rg = rsqrtf(sg * (1.f / 256.f) + EPS), ra = rsqrtf(sa * (1.f / 1024.f) + EPS);
            const int vcol = (16 * lane) & 255;
            f32x4 g4[4];
#pragma unroll
            for (int q4 = 0; q4 < 4; ++q4) g4[q4] = acc1_4(ACC1, s, 2048 + 16 * lane + 4 * q4);
            asm volatile("" ::: "memory");
#pragma unroll
            for (int e = 0; e < 16; e += 2) {
                const f32x4 gr4 = g4[e >> 2];
                const float g0 = gr4[e & 2] * rs1, g1 = gr4[(e & 2) + 1] * rs1;
                const float y0 = o[e] * rg * p.gla_norm_w[vcol + e] * (g0 / (1.f + __expf(-g0))), y1 = o[e + 1] * rg * p.gla_norm_w[vcol + e + 1] * (g1 / (1.f + __expf(-g1)));
                *(unsigned*)(CAT + (size_t)row * DM + 16 * lane + e) = cvt_pk_bf16(y0, y1);
                const float z0 = a[e] * ra * p.att_out_norm_w[16 * lane + e], z1 = a[e + 1] * ra * p.att_out_norm_w[16 * lane + e + 1];
                *(unsigned*)(CAT + (size_t)row * DM + 1024 + 16 * lane + e) = cvt_pk_bf16(z0, z1);
            }
        }
    }
}

__device__ __forceinline__ void gla_c_item(const P& p, LAS unsigned char* lds, int it, int tid) {
    unsigned char* ws = p.ws;
    const int wid = tid >> 6, lane = tid & 63, fr = lane & 15, fq = lane >> 4;
    const int bh = it >> 6, c = it & 63, b = bh >> 2, h = bh & 3;
    const int row0 = b * SEQ + 64 * c;
    LAS unsigned char* sQ = lds;
    LAS unsigned char* sK = lds + 16384;
    LAS unsigned char* sV = lds + 32768;
    LAS unsigned char* sS = lds + 65536;
    LAS unsigned char* sA = lds + 131072;
    LAS float* sRed = (LAS float*)(lds + 139264);
    __syncthreads();
    const bf16_t* GV = (const bf16_t*)(ws + O_GV);
#pragma unroll
    for (int i = 0; i < 4; ++i) { const int q = tid + 512 * i, row = q >> 5, ch32 = q & 31;
        const u32x4 v = *(const u32x4*)(GV + (size_t)(row0 + row) * 1024 + h * 256 + ch32 * 8);
        *(LAS u32x4*)(sV + (ch32 >> 4) * 16384 + offb(row, ch32 & 15)) = v; }
    const bf16_t* SC = (const bf16_t*)(ws + O_SC) + (size_t)it * 128 * 256;
#pragma unroll
    for (int i = 0; i < 8; ++i) { const int q = tid + 512 * i, row = q >> 5, ch32 = q & 31;
        const u32x4 v = *(const u32x4*)(SC + (size_t)row * 256 + ch32 * 8);
        *(LAS u32x4*)(sS + (ch32 >> 4) * 32768 + offb(row, ch32 & 15)) = v; }
    const bf16_t* GQ = (const bf16_t*)(ws + O_GQ); const bf16_t* GK = (const bf16_t*)(ws + O_GK); const float* BCUM = (const float*)(ws + O_BCUM);
#pragma unroll
    for (int i = 0; i < 2; ++i) { const int q = tid + 512 * i, t = q >> 4, ch = q & 15;
        const size_t go = (size_t)(row0 + t) * 512 + h * 128 + ch * 8;
        const u32x4 qr = *(const u32x4*)(GQ + go), kr = *(const u32x4*)(GK + go);
        const f32x4 b0 = *(const f32x4*)(BCUM + go), b1 = *(const f32x4*)(BCUM + go + 4);
        float e[8], ie[8];
#pragma unroll
        for (int j = 0; j < 4; ++j) { e[j] = __expf(b0[j]); e[4 + j] = __expf(b1[j]); ie[j] = __expf(-b0[j]); ie[4 + j] = __expf(-b1[j]); }
        u32x4 qo, ko;
        qo.x = cvt_pk_bf16(bflo(qr.x) * e[0], bfhi(qr.x) * e[1]); qo.y = cvt_pk_bf16(bflo(qr.y) * e[2], bfhi(qr.y) * e[3]);
        qo.z = cvt_pk_bf16(bflo(qr.z) * e[4], bfhi(qr.z) * e[5]); qo.w = cvt_pk_bf16(bflo(qr.w) * e[6], bfhi(qr.w) * e[7]);
        ko.x = cvt_pk_bf16(bflo(kr.x) * ie[0], bfhi(kr.x) * ie[1]); ko.y = cvt_pk_bf16(bflo(kr.y) * ie[2], bfhi(kr.y) * ie[3]);
        ko.z = cvt_pk_bf16(bflo(kr.z) * ie[4], bfhi(kr.z) * ie[5]); ko.w = cvt_pk_bf16(bflo(kr.w) * ie[6], bfhi(kr.w) * ie[7]);
        *(LAS u32x4*)(sQ + offb(t, ch)) = qo; *(LAS u32x4*)(sK + offb(t, ch)) = ko; }
    __syncthreads();
    { const int tb = wid >> 1;
#pragma unroll
      for (int sbi = 0; sbi < 2; ++sbi) { const int sb = (wid & 1) * 2 + sbi;
          f32x4 a = (f32x4){0.f, 0.f, 0.f, 0.f};
          if (sb <= tb) {
#pragma unroll
              for (int ks = 0; ks < 4; ++ks) { const bf16x8 kf = *(const LAS bf16x8*)(sK + offb(16 * sb + fr, 4 * ks + fq)); const bf16x8 qf = *(const LAS bf16x8*)(sQ + offb(16 * tb + fr, 4 * ks + fq)); a = mfma16(kf, qf, a); }
          }
          const int t = 16 * tb + fr;
#pragma unroll
          for (int j = 0; j < 4; ++j) { const int s = 16 * sb + 4 * fq + j; if (s > t) a[j] = 0.f; }
          u32x2 w; w.x = cvt_pk_bf16(a[0], a[1]); w.y = cvt_pk_bf16(a[2], a[3]);
          *(LAS u32x2*)(sA + t * 128 + (16 * sb + 4 * fq) * 2) = w; } }
    __syncthreads();
    f32x4 acc[2][4];
#pragma unroll
    for (int vi = 0; vi < 2; ++vi)
#pragma unroll
        for (int tb = 0; tb < 4; ++tb) acc[vi][tb] = (f32x4){0.f, 0.f, 0.f, 0.f};
    const unsigned q_ = (lane & 15) >> 2, pp = lane & 3;
    const unsigned sbase = (unsigned)(size_t)sS, vbase0 = (unsigned)(size_t)sV;
#pragma unroll
    for (int ks = 0; ks < 4; ++ks) {
        bf16x8 qf[4];
#pragma unroll
        for (int tb = 0; tb < 4; ++tb) qf[tb] = *(const LAS bf16x8*)(sQ + offb(16 * tb + fr, 4 * ks + fq));
        { const int vb = 2 * wid; const unsigned base = sbase + (vb >> 3) * 32768; const int cb = vb & 7;
            const unsigned R0 = 32 * ks + 8 * fq + q_; bf16x8 s0, s1;
            tr_read2x2(base + offb(R0, 2 * cb + (pp >> 1)) + 8 * (pp & 1), base + offb(R0 + 4, 2 * cb + (pp >> 1)) + 8 * (pp & 1),
                       base + offb(R0, 2 * cb + 2 + (pp >> 1)) + 8 * (pp & 1), base + offb(R0 + 4, 2 * cb + 2 + (pp >> 1)) + 8 * (pp & 1), s0, s1);
#pragma unroll
            for (int tb = 0; tb < 4; ++tb) { acc[0][tb] = mfma16(s0, qf[tb], acc[0][tb]); acc[1][tb] = mfma16(s1, qf[tb], acc[1][tb]); } }
    }
#pragma unroll
    for (int ks = 0; ks < 2; ++ks) {
        bf16x8 af[4];
#pragma unroll
        for (int tb = 0; tb < 4; ++tb) af[tb] = *(const LAS bf16x8*)(sA + (16 * tb + fr) * 128 + (32 * ks + 8 * fq) * 2);
        { const int vb = 2 * wid; const unsigned base = vbase0 + (vb >> 3) * 16384; const int cb = vb & 7;
            const unsigned R0 = 32 * ks + 8 * fq + q_; bf16x8 v0, v1;
            tr_read2x2(base + offb(R0, 2 * cb + (pp >> 1)) + 8 * (pp & 1), base + offb(R0 + 4, 2 * cb + (pp >> 1)) + 8 * (pp & 1),
                       base + offb(R0, 2 * cb + 2 + (pp >> 1)) + 8 * (pp & 1), base + offb(R0 + 4, 2 * cb + 2 + (pp >> 1)) + 8 * (pp & 1), v0, v1);
#pragma unroll
            for (int tb = 0; tb < 4; ++tb) { acc[0][tb] = mfma16(v0, af[tb], acc[0][tb]); acc[1][tb] = mfma16(v1, af[tb], acc[1][tb]); } }
    }
#pragma unroll
    for (int tb = 0; tb < 4; ++tb) { float ss = 0.f;
#pragma unroll
        for (int vi = 0; vi < 2; ++vi)
#pragma unroll
            for (int j = 0; j < 4; ++j) ss += acc[vi][tb][j] * acc[vi][tb][j];
        ss += __shfl_xor(ss, 16); ss += __shfl_xor(ss, 32);
        if (fq == 0) sRed[wid * 64 + 16 * tb + fr] = ss; }
    __syncthreads();
    const bf16_t* GG = (const bf16_t*)(ws + O_GG); bf16_t* CAT = (bf16_t*)(ws + O_CAT);
#pragma unroll
    for (int tb = 0; tb < 4; ++tb) { const int t = 16 * tb + fr; float tot = 0.f;
#pragma unroll
        for (int w8 = 0; w8 < 8; ++w8) tot += sRed[w8 * 64 + t];
        const float rs = rsqrtf(tot * (1.f / 256.f) + EPS);
#pragma unroll
        for (int vi = 0; vi < 2; ++vi) { const int v = 16 * (2 * wid + vi) + 4 * fq;
            const u32x2 gr = *(const u32x2*)(GG + (size_t)(row0 + t) * 1024 + h * 256 + v);
            const f32x4 nw = *(const f32x4*)(p.gla_norm_w + v);
            const float g0 = bflo(gr.x), g1 = bfhi(gr.x), g2 = bflo(gr.y), g3 = bfhi(gr.y);
            const f32x4 a = acc[vi][tb] * rs * nw;
            u32x2 w; w.x = cvt_pk_bf16(a[0] * (g0 / (1.f + __expf(-g0))), a[1] * (g1 / (1.f + __expf(-g1)))); w.y = cvt_pk_bf16(a[2] * (g2 / (1.f + __expf(-g2))), a[3] * (g3 / (1.f + __expf(-g3))));
            *(u32x2*)(CAT + (size_t)(row0 + t) * DM + h * 256 + v) = w; } }
}

__device__ __forceinline__ void sample_fin_x1(const P& p, LAS unsigned char* lds, int tid, int G) {
    unsigned char* ws = p.ws;
    const int wave = tid >> 6, lane = tid & 63;
    LAS float* red = (LAS float*)lds;
    for (int s = blockIdx.x; s < TS; s += G) {
        const int row = TP + s, c = tid * 4;
        f32x4 v = *(const f32x4*)(p.x_sample + (size_t)s * DM + c);
#pragma unroll
        for (int kp = 0; kp < 8; ++kp) v += *(const f32x4*)((const float*)(ws + O_ACCO) + ((size_t)kp * TS + s) * DM + c);
        const float ss = wave_sum((v[0] * v[0] + v[1] * v[1]) + (v[2] * v[2] + v[3] * v[3]));
        __syncthreads();
        if (lane == 0) red[wave] = ss;
        __syncthreads();
        if (tid == 0) { float tot = 0.f;
#pragma unroll
            for (int w8 = 0; w8 < 8; ++w8) tot += red[w8];
            ((float*)(ws + O_SUMS))[row] = tot; }
        u32x2 w; w.x = cvt_pk_bf16(v[0], v[1]); w.y = cvt_pk_bf16(v[2], v[3]);
        *(u32x2*)((bf16_t*)(ws + O_X1B) + (size_t)row * DM + c) = w;
        *(f32x4*)((float*)(ws + O_X1) + (size_t)row * DM + c) = v;
    }
}
__device__ __forceinline__ void sample_fin_h(const P& p, int tid, int G) {
    unsigned char* ws = p.ws;
    const float* ACCU = (const float*)(ws + O_ACCU); const float* ss2 = (const float*)(ws + O_SUMS); bf16_t* HM = (bf16_t*)(ws + O_HM);
    for (int i = blockIdx.x * NTHR + tid; i < TS * DFF / 8; i += G * NTHR) {
        const int s = i >> 10, c = (i & 1023) * 8;
        const float rs = rsqrtf(ss2[TP + s] * (1.f / DM) + EPS);
        f32x4 a = *(const f32x4*)(ACCU + (size_t)s * DFF + c), b = *(const f32x4*)(ACCU + (size_t)s * DFF + c + 4);
#pragma unroll
        for (int kp = 1; kp < 8; ++kp) { a += *(const f32x4*)(ACCU + ((size_t)kp * TS + s) * DFF + c); b += *(const f32x4*)(ACCU + ((size_t)kp * TS + s) * DFF + c + 4); }
        a = a * rs; b = b * rs;
#pragma unroll
        for (int j = 0; j < 4; ++j) { a[j] = fmaxf(a[j], 0.f); a[j] *= a[j]; b[j] = fmaxf(b[j], 0.f); b[j] *= b[j]; }
        u32x4 w; w.x = cvt_pk_bf16(a[0], a[1]); w.y = cvt_pk_bf16(a[2], a[3]); w.z = cvt_pk_bf16(b[0], b[1]); w.w = cvt_pk_bf16(b[2], b[3]);
        *(u32x4*)(HM + (size_t)(TP + s) * DFF + c) = w;
    }
}

__device__ __forceinline__ void phase8(const P& p, int tid, int base, int cnt) {
    const int wave = tid >> 6, lane = tid & 63;
    const bf16_t* X2B = (const bf16_t*)(p.ws + O_CAT);
    const int m1 = base + cnt;
    for (int mb = base + wave; mb < m1; mb += 32) {
        u32x4 raw[4][4];
#pragma unroll
        for (int q = 0; q < 4; ++q) { const int m = mb + q * 8;
            if (m < m1) { const u32x4* xr = (const u32x4*)(X2B + (size_t)m * DM);
#pragma unroll
                for (int j = 0; j < 4; ++j) raw[q][j] = __builtin_nontemporal_load(xr + lane + 64 * j); } }
        asm volatile("" ::: "memory");
#pragma unroll
        for (int q = 0; q < 4; ++q) { const int m = mb + q * 8;
            if (m < m1) {
                float v[32]; float s = 0.f;
#pragma unroll
                for (int j = 0; j < 4; ++j) { const u32x4 r = raw[q][j];
                    v[8 * j + 0] = bflo(r.x); v[8 * j + 1] = bfhi(r.x); v[8 * j + 2] = bflo(r.y); v[8 * j + 3] = bfhi(r.y);
                    v[8 * j + 4] = bflo(r.z); v[8 * j + 5] = bfhi(r.z); v[8 * j + 6] = bflo(r.w); v[8 * j + 7] = bfhi(r.w); }
#pragma unroll
                for (int e = 0; e < 32; ++e) s += v[e] * v[e];
                s = wave_sum(s);
                const float rs = rsqrtf(s * (1.f / DM) + EPS);
                float* yr = p.out + OUT_YP + (size_t)m * DM;
#pragma unroll
                for (int j = 0; j < 4; ++j) { const int c = (lane + 64 * j) * 8;
                    const f32x4 w0 = *(const f32x4*)(p.final_norm_w + c), w1 = *(const f32x4*)(p.final_norm_w + c + 4);
                    __builtin_nontemporal_store((f32x4){v[8 * j] * rs * w0[0], v[8 * j + 1] * rs * w0[1], v[8 * j + 2] * rs * w0[2], v[8 * j + 3] * rs * w0[3]}, (f32x4*)(yr + c));
                    __builtin_nontemporal_store((f32x4){v[8 * j + 4] * rs * w1[0], v[8 * j + 5] * rs * w1[1], v[8 * j + 6] * rs * w1[2], v[8 * j + 7] * rs * w1[3]}, (f32x4*)(yr + c + 4)); }
            } }
    }
}

#define XB_TMO      128
#define XB_XCNT(j)  (256  + 64 * (j))
#define XB_XSUB(j)  (1280 + 64 * (j))
#define XB_XGEN(j)  (2304 + 64 * (j))
#define XB_TOP      3328
#define XB_TOPGEN   3392
#define XCD_BAR_WORDS 3456
#define XB_SPIN_CAP (1u << 18)
__device__ __forceinline__ unsigned xb_ld(unsigned* p)              { return __hip_atomic_load(p, __ATOMIC_RELAXED, __HIP_MEMORY_SCOPE_AGENT); }
__device__ __forceinline__ unsigned xb_add(unsigned* p, unsigned v) { return __hip_atomic_fetch_add(p, v, __ATOMIC_RELAXED, __HIP_MEMORY_SCOPE_AGENT); }
__device__ __forceinline__ unsigned xb_xcc_id() { return (unsigned)__builtin_amdgcn_s_getreg((3 << 11) | 20) & 0xFu; }
#define XB_SPIN(cond, bar) do { unsigned _sp = 0; while (cond) { __builtin_amdgcn_s_sleep(1); \
    if ((++_sp & 255u) == 0u) { if (xb_ld(&(bar)[XB_TMO])) break; if (_sp > XB_SPIN_CAP) { atomicAdd(&(bar)[XB_TMO], 1u); break; } } } } while (0)
struct XcdBarrier { unsigned* bar; unsigned x; volatile LAS unsigned* st; };
__device__ __forceinline__ XcdBarrier xcd_barrier_post(unsigned* bar, volatile LAS unsigned* st) {
    XcdBarrier b; b.bar = bar; b.x = xb_xcc_id(); b.st = st;
    if (threadIdx.x == 0) (void)xb_add(&bar[XB_XCNT(b.x)], 1u);
    return b;
}
__device__ __forceinline__ void xcd_barrier_complete(unsigned* bar, unsigned x, unsigned& nloc, unsigned& nx) {
    const unsigned G = gridDim.x * gridDim.y * gridDim.z;
    unsigned sum, cnt, mine, sp = 0u;
    for (;;) {
        sum = 0u; cnt = 0u; mine = 0u;
#pragma unroll
        for (unsigned j = 0; j < 16; ++j) { const unsigned c = xb_ld(&bar[XB_XCNT(j)]); sum += c; cnt += (c > 0u) ? 1u : 0u; mine = (j == x) ? c : mine; }
        if (sum == G) break;
        __builtin_amdgcn_s_sleep(1);
        if ((++sp & 255u) == 0u) { if (xb_ld(&bar[XB_TMO])) break; if (sp > XB_SPIN_CAP) { atomicAdd(&bar[XB_TMO], 1u); break; } }
    }
    nloc = mine > 0u ? mine : 1u; nx = cnt > 0u ? cnt : 1u;
}
__device__ __forceinline__ void xcd_barrier(const XcdBarrier& b) {
    asm volatile("s_waitcnt vmcnt(0)" ::: "memory");
    __syncthreads();
    if (threadIdx.x == 0) {
        unsigned* bar = b.bar;
        __builtin_amdgcn_s_waitcnt(0);
        unsigned nloc = b.st[0], nx = b.st[1];
        if (nloc == 0u) { xcd_barrier_complete(bar, b.x, nloc, nx); b.st[0] = nloc; b.st[1] = nx; }
        const unsigned old = xb_add(&bar[XB_XSUB(b.x)], 1u);
        const unsigned gen = old / nloc;
        if (old + 1u == (gen + 1u) * nloc) {
            __builtin_amdgcn_fence(__ATOMIC_RELEASE, "agent");
            asm volatile("s_waitcnt vmcnt(0)" ::: "memory");
            const unsigned og = xb_add(&bar[XB_TOP], 1u);
            const unsigned tg = og / nx;
            if (og + 1u == (tg + 1u) * nx) xb_add(&bar[XB_TOPGEN], 1u);
            else XB_SPIN(xb_ld(&bar[XB_TOPGEN]) == tg, bar);
            __builtin_amdgcn_fence(__ATOMIC_ACQUIRE, "agent");
            xb_add(&bar[XB_XGEN(b.x)], 1u);
            asm volatile("s_waitcnt vmcnt(0)" ::: "memory");
        } else {
            XB_SPIN(xb_ld(&bar[XB_XGEN(b.x)]) == gen, bar);
            __builtin_amdgcn_fence(__ATOMIC_ACQUIRE, "agent");
            asm volatile("s_waitcnt vmcnt(0)" ::: "memory");
        }
    }
    __syncthreads();
}

__global__ void __launch_bounds__(NTHR) fwd_megakernel(P p) {
    extern __shared__ __attribute__((aligned(16))) unsigned char smem[];
    LAS unsigned char* lds = (LAS unsigned char*)smem;
    cg::grid_group grid = cg::this_grid();
    const int G = gridDim.x;
    unsigned char* ws = p.ws;
    if (threadIdx.x < 4) ((LAS unsigned*)(lds + LDS_BYTES - 16))[threadIdx.x] = 0u;
    __syncthreads();
    XcdBarrier xbar = xcd_barrier_post((unsigned*)(ws + O_BAR), (volatile LAS unsigned*)(lds + LDS_BYTES - 16));
    if (p.ws == nullptr) grid.sync();
#define GRID_SYNC() xcd_barrier(xbar)

    for (int rep = 0; rep < NREP(1); ++rep) { phase0(p, lds, fresh_tid(), G); __syncthreads(); }
    GRID_SYNC();

    {
        pg8::StaticOrder S; S.init((const bf16_t*)(ws + O_XB), (const bf16_t*)(ws + O_BT1), TP, N1, DM, G, (int)blockIdx.x);
        pg8::PieceOrder SP; SP.init((const bf16_t*)(ws + O_XB) + (size_t)TP * DM, (const bf16_t*)(ws + O_BT1), N1, DM, 256, G, (int)blockIdx.x);
        pg8::CombOrder SC; SC.init(S, SP, DM / 64, 4);
        LAS float* rsL = (LAS float*)(lds + 131072);
        { const int t0 = fresh_tid(); const float* rstd1 = (const float*)(ws + O_RSTD1);
          for (int idx = t0; idx < SC.ns * 256; idx += NTHR) { pg8::Unit u; S.next(idx >> 8, u); rsL[idx] = rstd1[u.pm * 256 + (idx & 255)]; }
          __syncthreads(); }
        EpiBoth<Epi1> E{Epi1{p, rsL}, EpiPartP{(float*)(ws + O_ACC1), N1}};
        pg8::gemm_phase<EpiBoth<Epi1>, pg8::CombOrder>(lds, pg8::Gemm{DM, DM / 64}, SC, E);
        for (int rep = 0; rep < NREP(4); ++rep) phase1_skinny(p, lds, fresh_tid(), G);
    }
    GRID_SYNC();

    {
        { const int t0 = fresh_tid(); const int w = __builtin_amdgcn_readfirstlane(t0 >> 6);
          __syncthreads();
          if (w < 4) { for (int wi = w * G + blockIdx.x; wi < 1024; wi += G * 4) attn_sample_item(p, wi, t0 & 63); }
          else side_transposes(p, lds, w - 4, t0 & 63, G); }
        for (int rep = 0; rep < NREP(16); ++rep) { const int t0 = fresh_tid(); for (int it = blockIdx.x; it < 256; it += G) gla_sample_item(p, lds, it, t0); }
        for (int rep = 0; rep < NREP(32); ++rep) { const int t0 = fresh_tid(); for (int it = blockIdx.x; it < 512; it += G) gla_a_item(p, lds, it, t0); }
        for (int rep = 0; rep < NREP(64); ++rep) attn_prompt_loop(p, lds, fresh_tid(), G);
    }
    GRID_SYNC();

    for (int rep = 0; rep < NREP(128); ++rep) phase3(p, fresh_tid(), G);
    GRID_SYNC();

    for (int rep = 0; rep < NREP(256); ++rep) { const int t0 = fresh_tid(); for (int it = blockIdx.x; it < 512; it += G) gla_c_item(p, lds, it, t0); }
    __syncthreads();
    {
        pg8::PieceOrder SP; SP.init((const bf16_t*)(ws + O_CAT) + (size_t)TP * DM, (const bf16_t*)(ws + O_BTO), DM, DM, 256, G, (int)blockIdx.x);
        EpiPart EA{(float*)(ws + O_ACCO), DM};
        pg8::gemm_phase<EpiPart, pg8::PieceOrder>(lds, pg8::Gemm{DM, 4}, SP, EA);
    }
    GRID_SYNC();

    {
        pg8::StaticOrder S; S.init((const bf16_t*)(ws + O_CAT), (const bf16_t*)(ws + O_BTO), TP, DM, DM, G, (int)blockIdx.x);
        EpiO E{p};
        pg8::gemm_phase<EpiO, pg8::StaticOrder>(lds, pg8::Gemm{DM, DM / 64}, S, E);
        sample_fin_x1(p, lds, fresh_tid(), G);
    }
    GRID_SYNC();

    {
        pg8::StaticOrder S; S.init((const bf16_t*)(ws + O_X1B), (const bf16_t*)(ws + O_BTU), TP, DFF, DM, G, (int)blockIdx.x);
        pg8::PieceOrder SP; SP.init((const bf16_t*)(ws + O_X1B) + (size_t)TP * DM, (const bf16_t*)(ws + O_BTU), DFF, DM, 256, G, (int)blockIdx.x);
        pg8::CombOrder SC; SC.init(S, SP, DM / 64, 4);
        LAS float* rsL = (LAS float*)(lds + 131072);
        { const int t0 = fresh_tid(); const float* ss2 = (const float*)(ws + O_SUMS);
          for (int idx = t0; idx < SC.ns * 256; idx += NTHR) { pg8::Unit u; S.next(idx >> 8, u); rsL[idx] = rsqrtf(ss2[u.pm * 256 + (idx & 255)] * (1.f / DM) + EPS); }
          __syncthreads(); }
        EpiBoth<EpiU> E{EpiU{p, rsL}, EpiPartP{(float*)(ws + O_ACCU), DFF}};
        pg8::gemm_phase<EpiBoth<EpiU>, pg8::CombOrder>(lds, pg8::Gemm{DM, DM / 64}, SC, E);
    }
    GRID_SYNC();

    {
        pg8::StaticOrder S; S.init((const bf16_t*)(ws + O_HM), (const bf16_t*)(ws + O_BTD), TP, DM, DFF, G, (int)blockIdx.x);
        EpiD E{p};
        for (int rep = 0; rep < NREP(2048); ++rep) pg8::gemm_phase<EpiD, pg8::StaticOrder>(lds, pg8::Gemm{DFF, DFF / 64}, S, E);
        sample_fin_h(p, fresh_tid(), G);
    }
    GRID_SYNC();

    {
        pg8::PieceOrder SP; SP.init((const bf16_t*)(ws + O_HM) + (size_t)TP * DFF, (const bf16_t*)(ws + O_BTD), DM, DFF, 512, G, (int)blockIdx.x);
        EpiPart EA{(float*)(ws + O_ACCD), DM};
        pg8::gemm_phase<EpiPart, pg8::PieceOrder>(lds, pg8::Gemm{DFF, 8}, SP, EA);
        int base, cnt; const int c = (int)blockIdx.x;
        if (G == 256) { if (c < 128) { base = c * 20; cnt = 20; } else { base = 2560 + (c - 128) * 44; cnt = 44; } }
        else { const int per = (TP + G - 1) / G; base = c * per; cnt = base + per <= TP ? per : (TP > base ? TP - base : 0); }
        phase8(p, fresh_tid(), base, cnt);
    }
    GRID_SYNC();

    if (REP_MASK & 4096) { for (int rep = 0; rep < 10; ++rep) GRID_SYNC(); }
    {
        const int tid = fresh_tid(), wave = tid >> 6, lane = tid & 63;
        LAS float* red = (LAS float*)lds;
        for (int s = blockIdx.x; s < TS; s += G) {
            const int c = tid * 4;
            f32x4 v = *(const f32x4*)((const float*)(ws + O_X1) + (size_t)(TP + s) * DM + c);
#pragma unroll
            for (int kp = 0; kp < 16; ++kp) v += *(const f32x4*)((const float*)(ws + O_ACCD) + ((size_t)kp * TS + s) * DM + c);
            float ss = wave_sum((v[0] * v[0] + v[1] * v[1]) + (v[2] * v[2] + v[3] * v[3]));
            __syncthreads();
            if (lane == 0) red[wave] = ss;
            __syncthreads();
            float tot = 0.f;
#pragma unroll
            for (int w8 = 0; w8 < 8; ++w8) tot += red[w8];
            const float rs = rsqrtf(tot * (1.f / DM) + EPS);
            *(f32x4*)(p.out + OUT_YS + (size_t)s * DM + c) = v * rs * *(const f32x4*)(p.final_norm_w + c);
        }
    }
}

extern "C" void kernel_launch(void* const* d_in, const int* in_sizes, int n_in, void* d_out, int out_size, void* d_ws, size_t ws_size, hipStream_t stream) {
    static int grid_blocks = 0;
    if (!grid_blocks) {
        int dev = 0, cus = 0, per_cu = 0;
        hipGetDevice(&dev);
        hipDeviceGetAttribute(&cus, hipDeviceAttributeMultiprocessorCount, dev);
        hipFuncSetAttribute((const void*)fwd_megakernel, hipFuncAttributeMaxDynamicSharedMemorySize, LDS_BYTES);
        hipOccupancyMaxActiveBlocksPerMultiprocessor(&per_cu, (const void*)fwd_megakernel, NTHR, LDS_BYTES);
        if (per_cu < 1) per_cu = 1;
        grid_blocks = cus * per_cu;
        if (ws_size < WS_END) fprintf(stderr, "workspace too small: %zu < %zu\n", ws_size, (size_t)WS_END);
    }
    P p{};
    p.x_prompt = (const float*)d_in[0]; p.x_sample = (const float*)d_in[1]; p.cache_k = (const float*)d_in[2]; p.cache_v = (const float*)d_in[3];
    p.state_gla = (const float*)d_in[4]; p.attn_norm_w = (const float*)d_in[5]; p.w_in = (const float*)d_in[6]; p.w_gk_up = (const float*)d_in[7];
    p.b_gk = (const float*)d_in[8]; p.gla_norm_w = (const float*)d_in[9]; p.att_out_norm_w = (const float*)d_in[10]; p.w_out = (const float*)d_in[11];
    p.ffn_norm_w = (const float*)d_in[12]; p.w_up = (const float*)d_in[13]; p.w_down = (const float*)d_in[14]; p.final_norm_w = (const float*)d_in[15];
    p.out = (float*)d_out; p.ws = (unsigned char*)d_ws;
    hipMemsetAsync((char*)d_ws + O_BAR, 0, 16384, stream);
    void* args[] = {&p};
    hipError_t e = hipLaunchCooperativeKernel((const void*)fwd_megakernel, dim3(grid_blocks), dim3(NTHR), args, LDS_BYTES, stream);
    if (e != hipSuccess) fprintf(stderr, "cooperative launch failed: %s (grid %d)\n", hipGetErrorString(e), grid_blocks);
}
```
